# Optimizing an MI355X kernel written in HIP

```python
import jax, jax.numpy as jnp
from jax import lax
import numpy as np

D_MODEL = 1024
BATCH = 8
SEQ = 4096
DEPTH = 4

MEM_LEN = 256
LRU_WIDTH = D_MODEL // 2
LRU_BLOCKS = 8
LRU_BLOCK_DIM = LRU_WIDTH // LRU_BLOCKS
LRU_CONV = 4
LRU_C = 8.0
NSA_HEADS = 8
NSA_KV_HEADS = 2
HEAD_DIM = 64
CMP_LEN = 32
CMP_STRIDE = 16
CMP_HIDDEN = 128
SEL_BLOCK = 64
SEL_TOP = 16
WINDOW = 512
NSA_QBLOCK = 64
ROPE_THETA = 500000.0
ROT_DIM = HEAD_DIM // 4
SC_WIDTH = D_MODEL
SC_CONV = 3
XA_HEADS = 4
XA_HEAD_DIM = D_MODEL // XA_HEADS
N_GROUPS = 4
EXPERTS_PER_GROUP = 4
N_EXPERTS = N_GROUPS * EXPERTS_PER_GROUP
TOP_K = 2
D_EXPERT = D_MODEL // 2

EPS = 1e-6
NEG = -1e30
FORCE = 1e9
N_EVEN = (DEPTH + 1) // 2
N_ODD = DEPTH // 2
MIX_WIDTH = LRU_WIDTH + NSA_HEADS * HEAD_DIM
EVEN_SPLITS = (LRU_WIDTH, LRU_WIDTH, NSA_HEADS * HEAD_DIM) + (NSA_KV_HEADS * HEAD_DIM,) * 6 + (NSA_HEADS * 3,)
EVEN_PROJ = int(sum(EVEN_SPLITS))
EVEN_OFFSETS = tuple(int(o) for o in np.cumsum(EVEN_SPLITS)[:-1])

kernel_name = 'hybrid_rglru_nsa_shortconv_hmoe'


def rms_norm(x, g):
    x32 = x.astype(jnp.float32)
    y = x32 * lax.rsqrt(jnp.mean(x32 * x32, axis=-1, keepdims=True) + EPS)
    return (y * g.astype(jnp.float32)).astype(x.dtype)


def rope_tables(positions):
    inv = ROPE_THETA ** (-jnp.arange(0, ROT_DIM, 2, dtype=jnp.float32) / ROT_DIM)
    ang = positions.astype(jnp.float32)[..., None] * inv
    return jnp.cos(ang), jnp.sin(ang)


def apply_partial_rope(x, cos, sin):
    half = ROT_DIM // 2
    c = cos[:, :, None, :].astype(x.dtype)
    s = sin[:, :, None, :].astype(x.dtype)
    x1 = x[..., :half]
    x2 = x[..., half:ROT_DIM]
    return jnp.concatenate([x1 * c - x2 * s, x2 * c + x1 * s, x[..., ROT_DIM:]], axis=-1)


def causal_dwconv(x, w, b=None):
    width, ch = w.shape
    y = lax.conv_general_dilated(x, w[:, None, :].astype(x.dtype), window_strides=(1,),
                                 padding=[(width - 1, 0)],
                                 dimension_numbers=('NWC', 'WIO', 'NWC'),
                                 feature_group_count=ch)
    if b is not None:
        y = y + b.astype(x.dtype)
    return y


def masked_softmax(s, mask):
    p = jax.nn.softmax(jnp.where(mask, s, NEG), axis=-1)
    return jnp.where(mask, p, 0.0)


def rg_lru(x, gate_branch, conv_w, conv_b, w_r, b_r, w_i, b_i, lam):
    xc = causal_dwconv(x, conv_w, conv_b)
    bb, t, w = xc.shape
    xb = xc.reshape(bb, t, LRU_BLOCKS, LRU_BLOCK_DIM)
    r = jax.nn.sigmoid(jnp.einsum('btki,kij->btkj', xb, w_r).reshape(bb, t, w) + b_r)
    i = jax.nn.sigmoid(jnp.einsum('btki,kij->btkj', xb, w_i).reshape(bb, t, w) + b_i)
    log_a = -LRU_C * r.astype(jnp.float32) * jax.nn.softplus(-lam.astype(jnp.float32))
    a = jnp.exp(log_a)
    u = jnp.sqrt(-jnp.expm1(2.0 * log_a)) * (i * xc).astype(jnp.float32)

    def combine(left, right):
        a1, b1 = left
        a2, b2 = right
        return a1 * a2, a2 * b1 + b2

    _, h = lax.associative_scan(combine, (a, u), axis=1)
    return h.astype(x.dtype) * jax.nn.gelu(gate_branch)


def compress_kv(kv, pos_emb, w1, w2):
    bb, t, g, dh = kv.shape
    ch = kv.reshape(bb, t // CMP_STRIDE, CMP_STRIDE, g, dh)
    blocks = jnp.concatenate([ch[:, :-1], ch[:, 1:]], axis=2)
    blocks = blocks + pos_emb[None, None, :, None, :]
    ncmp = blocks.shape[1]
    flat = blocks.transpose(0, 3, 1, 2, 4).reshape(bb, g, ncmp, CMP_LEN * dh)
    return jax.nn.gelu(flat @ w1) @ w2


def nsa(q, k_cmp, v_cmp, k_sel, v_sel, k_win, v_win, gate_logits, cos, sin,
        pos_k, w1_k, w2_k, pos_v, w1_v, w2_v):
    bb, t, nh, dh = q.shape
    g = k_cmp.shape[2]
    hg = nh // g
    scale = dh ** -0.5
    kc = compress_kv(k_cmp, pos_k, w1_k, w2_k)
    vc = compress_kv(v_cmp, pos_v, w1_v, w2_v)
    n_cmp = kc.shape[2]
    n_sel = t // SEL_BLOCK
    n_top = min(SEL_TOP, n_sel)
    cmp_start = jnp.arange(n_cmp) * CMP_STRIDE
    cmp_end = cmp_start + CMP_LEN - 1
    sel_start = jnp.arange(n_sel) * SEL_BLOCK
    cover = ((cmp_start[:, None] <= sel_start[None, :] + SEL_BLOCK - 1)
             & (cmp_end[:, None] >= sel_start[None, :])).astype(jnp.float32)

    def kv_major(z):
        return z.transpose(0, 2, 1, 3)

    ks = kv_major(apply_partial_rope(k_sel, cos, sin)).reshape(bb, g, n_sel, SEL_BLOCK, dh)
    vs = kv_major(v_sel).reshape(bb, g, n_sel, SEL_BLOCK, dh)
    pad = ((0, 0), (0, 0), (WINDOW, 0), (0, 0))
    kw = jnp.pad(kv_major(apply_partial_rope(k_win, cos, sin)), pad)
    vw = jnp.pad(kv_major(v_win), pad)

    def by_query_block(z):
        c = z.shape[-1]
        z = z.reshape(bb, t // NSA_QBLOCK, NSA_QBLOCK, g, hg, c)
        return z.transpose(1, 0, 3, 4, 2, 5)

    qn = by_query_block(q)
    qr = by_query_block(apply_partial_rope(q, cos, sin))
    gt = by_query_block(jax.nn.sigmoid(gate_logits.astype(jnp.float32)).astype(q.dtype))
    b_ix = jnp.arange(bb)[:, None, None, None]
    g_ix = jnp.arange(g)[None, :, None, None]
    blk = jnp.arange(n_sel)
    ar_sel = jnp.arange(SEL_BLOCK)
    ar_win = jnp.arange(NSA_QBLOCK + WINDOW)

    def block(args):
        c, qn_c, qr_c, g_c = args
        tq = c * NSA_QBLOCK + jnp.arange(NSA_QBLOCK)
        s = jnp.einsum('bghqd,bgnd->bghqn', qn_c, kc).astype(jnp.float32) * scale
        p_cmp = masked_softmax(s, cmp_end[None, :] <= tq[:, None])
        o_cmp = jnp.einsum('bghqn,bgnd->bghqd', p_cmp.astype(vc.dtype), vc)
        imp = jnp.einsum('bghqn,ns->bgqs', p_cmp, cover)
        cur = tq // SEL_BLOCK
        forced = (blk[None, :] == 0) | (blk[None, :] == cur[:, None]) | (blk[None, :] == cur[:, None] - 1)
        causal = sel_start[None, :] <= tq[:, None]
        score = jnp.where(causal, jnp.where(forced, FORCE, imp), NEG)
        _, idx = lax.top_k(score, n_top)
        ksg = ks[b_ix, g_ix, idx]
        vsg = vs[b_ix, g_ix, idx]
        key_pos = idx[..., None] * SEL_BLOCK + ar_sel
        m_sel = (key_pos <= tq[:, None, None]).reshape(bb, g, 1, NSA_QBLOCK, n_top * SEL_BLOCK)
        s_sel = jnp.einsum('bghqd,bgqnkd->bghqnk', qr_c, ksg).astype(jnp.float32) * scale
        shp = s_sel.shape
        p_sel = masked_softmax(s_sel.reshape(bb, g, hg, NSA_QBLOCK, n_top * SEL_BLOCK), m_sel).reshape(shp)
        o_sel = jnp.einsum('bghqnk,bgqnkd->bghqd', p_sel.astype(vsg.dtype), vsg)
        start = c * NSA_QBLOCK
        kwc = lax.dynamic_slice_in_dim(kw, start, NSA_QBLOCK + WINDOW, axis=2)
        vwc = lax.dynamic_slice_in_dim(vw, start, NSA_QBLOCK + WINDOW, axis=2)
        kpos = start - WINDOW + ar_win
        m_w = ((kpos[None, :] >= 0) & (kpos[None, :] <= tq[:, None])
               & (kpos[None, :] > tq[:, None] - WINDOW))
        s_w = jnp.einsum('bghqd,bgkd->bghqk', qr_c, kwc).astype(jnp.float32) * scale
        p_w = masked_softmax(s_w, m_w)
        o_w = jnp.einsum('bghqk,bgkd->bghqd', p_w.astype(vwc.dtype), vwc)
        return g_c[..., 0:1] * o_cmp + g_c[..., 1:2] * o_sel + g_c[..., 2:3] * o_w

    out = lax.map(block, (jnp.arange(t // NSA_QBLOCK), qn, qr, gt))
    return out.transpose(1, 0, 4, 2, 3, 5).reshape(bb, t, nh * dh)


def even_mixer(xn, w_in, w_out, conv_w, conv_b, w_r, b_r, w_i, b_i, lam,
               pos_k, w1_k, w2_k, pos_v, w1_v, w2_v, cos, sin):
    bb, t, _ = xn.shape
    parts = jnp.split(xn @ w_in, EVEN_OFFSETS, axis=-1)
    x_lru, g_lru, q, kc, vc, ks, vs, kw, vw, gl = parts
    y_lru = rg_lru(x_lru, g_lru, conv_w, conv_b, w_r, b_r, w_i, b_i, lam)

    def kvh(z):
        return z.reshape(bb, t, NSA_KV_HEADS, HEAD_DIM)

    y_nsa = nsa(q.reshape(bb, t, NSA_HEADS, HEAD_DIM), kvh(kc), kvh(vc), kvh(ks), kvh(vs),
                kvh(kw), kvh(vw), gl.reshape(bb, t, NSA_HEADS, 3), cos, sin,
                pos_k, w1_k, w2_k, pos_v, w1_v, w2_v)
    return jnp.concatenate([y_lru, y_nsa], axis=-1) @ w_out


def short_conv_mixer(xn, w_in, conv_w, w_out):
    b_g, c_g, v = jnp.split(xn @ w_in, 3, axis=-1)
    return (b_g * causal_dwconv(c_g * v, conv_w)) @ w_out


def memory_cross_attn(xn, mem, g_mem, wq, wk, wv, wo):
    bb, t, _ = xn.shape
    mn = rms_norm(mem, g_mem)
    q = (xn @ wq).reshape(bb, t, XA_HEADS, XA_HEAD_DIM)
    k = (mn @ wk).reshape(bb, -1, XA_HEADS, XA_HEAD_DIM)
    v = (mn @ wv).reshape(bb, -1, XA_HEADS, XA_HEAD_DIM)
    s = jnp.einsum('bthd,bmhd->bhtm', q, k).astype(jnp.float32) * (XA_HEAD_DIM ** -0.5)
    p = jax.nn.softmax(s, axis=-1).astype(v.dtype)
    o = jnp.einsum('bhtm,bmhd->bthd', p, v).reshape(bb, t, XA_HEADS * XA_HEAD_DIM)
    return o @ wo


def hier_moe(xn, w_group, b_group, w_expert, b_expert, w_gate, w_up, w_down):
    bb, t, d = xn.shape
    xt = xn.reshape(-1, d)
    n = xt.shape[0]
    g_prob = jax.nn.softmax((xt @ w_group).astype(jnp.float32) + b_group.astype(jnp.float32), axis=-1)
    g_top, g_idx = lax.top_k(g_prob, 1)
    e_logits = ((xt @ w_expert).astype(jnp.float32) + b_expert.astype(jnp.float32)).reshape(n, N_GROUPS, EXPERTS_PER_GROUP)
    e_in = e_logits[jnp.arange(n), g_idx[:, 0]]
    e_top, e_idx = lax.top_k(e_in, TOP_K)
    w = jax.nn.softmax(e_top, axis=-1) * g_top
    eid = g_idx * EXPERTS_PER_GROUP + e_idx
    gate = jnp.sum(jax.nn.one_hot(eid, N_EXPERTS, dtype=jnp.float32) * w[..., None], axis=1).astype(xn.dtype)
    y = jnp.zeros_like(xt)
    for e in range(N_EXPERTS):
        h = jax.nn.silu(xt @ w_gate[e]) * (xt @ w_up[e])
        y = y + gate[:, e:e + 1] * (h @ w_down[e])
    return y.reshape(bb, t, d)


def setup_inputs(seed: int = 0) -> dict:
    key = jax.random.key(seed)
    keys = iter(jax.random.split(key, 64))
    res = (3 * DEPTH) ** -0.5

    def nrm(shape, scale):
        return jax.random.normal(next(keys), shape, jnp.float32) * scale

    def gain(shape):
        return 1.0 + nrm(shape, 0.02)

    def lru_lambda():
        u = jax.random.uniform(next(keys), (N_EVEN, LRU_WIDTH), jnp.float32, 0.9, 0.999)
        a = u ** (1.0 / LRU_C)
        return jnp.log(a) - jnp.log1p(-a)

    offset = jax.random.randint(next(keys), (BATCH, 1), 0, 1024)
    positions = (offset + jnp.arange(SEQ)[None, :]).astype(jnp.int32)
    return {
        'x': nrm((BATCH, SEQ, D_MODEL), 1.0),
        'mem': nrm((BATCH, MEM_LEN, D_MODEL), 1.0),
        'positions': positions,
        'norm_mix': gain((DEPTH, D_MODEL)),
        'norm_xattn': gain((DEPTH, D_MODEL)),
        'norm_mem': gain((DEPTH, D_MODEL)),
        'norm_ffn': gain((DEPTH, D_MODEL)),
        'norm_final': gain((D_MODEL,)),
        'even_w_in': nrm((N_EVEN, D_MODEL, EVEN_PROJ), D_MODEL ** -0.5),
        'even_w_out': nrm((N_EVEN, MIX_WIDTH, D_MODEL), MIX_WIDTH ** -0.5 * res),
        'lru_conv_w': nrm((N_EVEN, LRU_CONV, LRU_WIDTH), LRU_CONV ** -0.5),
        'lru_conv_b': nrm((N_EVEN, LRU_WIDTH), 0.01),
        'lru_w_r': nrm((N_EVEN, LRU_BLOCKS, LRU_BLOCK_DIM, LRU_BLOCK_DIM), LRU_BLOCK_DIM ** -0.5),
        'lru_b_r': nrm((N_EVEN, LRU_WIDTH), 0.01),
        'lru_w_i': nrm((N_EVEN, LRU_BLOCKS, LRU_BLOCK_DIM, LRU_BLOCK_DIM), LRU_BLOCK_DIM ** -0.5),
        'lru_b_i': nrm((N_EVEN, LRU_WIDTH), 0.01),
        'lru_lambda': lru_lambda(),
        'nsa_cmp_pos_k': nrm((N_EVEN, CMP_LEN, HEAD_DIM), 0.02),
        'nsa_cmp_w1_k': nrm((N_EVEN, CMP_LEN * HEAD_DIM, CMP_HIDDEN), (CMP_LEN * HEAD_DIM) ** -0.5),
        'nsa_cmp_w2_k': nrm((N_EVEN, CMP_HIDDEN, HEAD_DIM), CMP_HIDDEN ** -0.5),
        'nsa_cmp_pos_v': nrm((N_EVEN, CMP_LEN, HEAD_DIM), 0.02),
        'nsa_cmp_w1_v': nrm((N_EVEN, CMP_LEN * HEAD_DIM, CMP_HIDDEN), (CMP_LEN * HEAD_DIM) ** -0.5),
        'nsa_cmp_w2_v': nrm((N_EVEN, CMP_HIDDEN, HEAD_DIM), CMP_HIDDEN ** -0.5),
        'odd_w_in': nrm((N_ODD, D_MODEL, 3 * SC_WIDTH), D_MODEL ** -0.5),
        'odd_conv_w': nrm((N_ODD, SC_CONV, SC_WIDTH), SC_CONV ** -0.5),
        'odd_w_out': nrm((N_ODD, SC_WIDTH, D_MODEL), SC_WIDTH ** -0.5 * res),
        'xa_wq': nrm((DEPTH, D_MODEL, XA_HEADS * XA_HEAD_DIM), D_MODEL ** -0.5),
        'xa_wk': nrm((DEPTH, D_MODEL, XA_HEADS * XA_HEAD_DIM), D_MODEL ** -0.5),
        'xa_wv': nrm((DEPTH, D_MODEL, XA_HEADS * XA_HEAD_DIM), D_MODEL ** -0.5),
        'xa_wo': nrm((DEPTH, XA_HEADS * XA_HEAD_DIM, D_MODEL), (XA_HEADS * XA_HEAD_DIM) ** -0.5 * res),
        'moe_w_group': nrm((DEPTH, D_MODEL, N_GROUPS), D_MODEL ** -0.5),
        'moe_b_group': nrm((DEPTH, N_GROUPS), 0.01),
        'moe_w_expert': nrm((DEPTH, D_MODEL, N_EXPERTS), D_MODEL ** -0.5),
        'moe_b_expert': nrm((DEPTH, N_EXPERTS), 0.01),
        'moe_w_gate': nrm((DEPTH, N_EXPERTS, D_MODEL, D_EXPERT), D_MODEL ** -0.5),
        'moe_w_up': nrm((DEPTH, N_EXPERTS, D_MODEL, D_EXPERT), D_MODEL ** -0.5),
        'moe_w_down': nrm((DEPTH, N_EXPERTS, D_EXPERT, D_MODEL), D_EXPERT ** -0.5 * res),
    }


def reference(x, mem, positions, norm_mix, norm_xattn, norm_mem, norm_ffn, norm_final,
              even_w_in, even_w_out, lru_conv_w, lru_conv_b, lru_w_r, lru_b_r, lru_w_i, lru_b_i,
              lru_lambda, nsa_cmp_pos_k, nsa_cmp_w1_k, nsa_cmp_w2_k, nsa_cmp_pos_v, nsa_cmp_w1_v,
              nsa_cmp_w2_v, odd_w_in, odd_conv_w, odd_w_out, xa_wq, xa_wk, xa_wv, xa_wo,
              moe_w_group, moe_b_group, moe_w_expert, moe_b_expert, moe_w_gate, moe_w_up, moe_w_down):
    cos, sin = rope_tables(positions)
    h = x
    for layer in range(DEPTH):
        xn = rms_norm(h, norm_mix[layer])
        if layer % 2 == 0:
            e = layer // 2
            h = h + even_mixer(xn, even_w_in[e], even_w_out[e], lru_conv_w[e], lru_conv_b[e],
                               lru_w_r[e], lru_b_r[e], lru_w_i[e], lru_b_i[e], lru_lambda[e],
                               nsa_cmp_pos_k[e], nsa_cmp_w1_k[e], nsa_cmp_w2_k[e],
                               nsa_cmp_pos_v[e], nsa_cmp_w1_v[e], nsa_cmp_w2_v[e], cos, sin)
        else:
            o = layer // 2
            h = h + short_conv_mixer(xn, odd_w_in[o], odd_conv_w[o], odd_w_out[o])
        h = h + memory_cross_attn(rms_norm(h, norm_xattn[layer]), mem, norm_mem[layer],
                                  xa_wq[layer], xa_wk[layer], xa_wv[layer], xa_wo[layer])
        h = h + hier_moe(rms_norm(h, norm_ffn[layer]), moe_w_group[layer], moe_b_group[layer],
                         moe_w_expert[layer], moe_b_expert[layer], moe_w_gate[layer],
                         moe_w_up[layer], moe_w_down[layer])
    return rms_norm(h, norm_final)
```

```cpp
#include <hip/hip_runtime.h>
#include <stdio.h>

#ifndef MK_PER_PHASE
#define MK_PER_PHASE 0
#endif

#define LAS __attribute__((address_space(3)))
typedef unsigned short bf16_t;
typedef short bf16x8 __attribute__((ext_vector_type(8)));
typedef short bf16x4 __attribute__((ext_vector_type(4)));
typedef float f32x2 __attribute__((ext_vector_type(2)));
typedef float f32x4 __attribute__((ext_vector_type(4)));
typedef float f32x16 __attribute__((ext_vector_type(16)));
typedef unsigned u32x2 __attribute__((ext_vector_type(2)));
typedef unsigned u32x4 __attribute__((ext_vector_type(4)));

constexpr int DM = 1024, NB = 8, SEQ = 4096, NTOK = NB * SEQ, DEPTH = 4, MEMLEN = 256;
constexpr int EPROJ = 2328;
constexpr int PA_N = 2048;
constexpr int PB_N = 512;
constexpr float EPS = 1e-6f;

constexpr size_t MiB = 1u << 20;
constexpr size_t WS_CTL = 0, CTL_BYTES = 1 * MiB;
constexpr size_t WS_W_EINA = 1 * MiB;
constexpr size_t WS_W_EINB = 9 * MiB;
constexpr size_t WS_W_EOUT = 11 * MiB;
constexpr size_t WS_W_OIN = 15 * MiB;
constexpr size_t WS_W_OOUT = 27 * MiB;
constexpr size_t WS_W_XQ = 31 * MiB, WS_W_XK = 39 * MiB, WS_W_XV = 47 * MiB, WS_W_XO = 55 * MiB;
constexpr size_t WS_W_RT = 63 * MiB;
constexpr size_t WS_W_LRU = 64 * MiB;
constexpr size_t WS_W_CMP1 = 65 * MiB;
constexpr size_t WS_W_CMP2 = 67 * MiB;
constexpr size_t WS_MOE_GU = 68 * MiB;
constexpr size_t WS_MOE_D = 100 * MiB;
constexpr size_t WS_XK = 116 * MiB;
constexpr size_t WS_XVT = 132 * MiB;
constexpr size_t WS_MNHAT = 148 * MiB;
constexpr size_t WS_ROPE = 152 * MiB;
constexpr size_t WS_SSQ = 154 * MiB;
constexpr size_t WS_LRUAGG = 156 * MiB;
constexpr size_t WS_KCMP = 158 * MiB;
constexpr size_t WS_ROUTE = 159 * MiB;
constexpr size_t WS_PERM = 160 * MiB;
constexpr size_t WS_HB = 164 * MiB;
constexpr size_t WS_YMIX = 228 * MiB;
constexpr size_t WS_RA = 292 * MiB;
constexpr size_t WS_MOE_GU2 = 452 * MiB;
constexpr size_t WS_MOE_D2 = 484 * MiB;
constexpr size_t WS_END = 500 * MiB;
constexpr size_t RA_PROJB = 128 * MiB;
constexpr int HMID_ROWS = 2 * NTOK + 32 * 256;

constexpr int CW_BAR = 4096;
constexpr int CW_Q = 20480;
constexpr int CW_CNT = 16384;

constexpr int LDS_STAGE = 131072;
constexpr int LDS_MISC = 143360;
constexpr int LDS_BYTES = 145408;

typedef __bf16 bf16x2n __attribute__((ext_vector_type(2)));
__device__ __forceinline__ unsigned cvt_pk_bf16(float lo, float hi) { const f32x2 v = {lo, hi}; return __builtin_bit_cast(unsigned, __builtin_convertvector(v, bf16x2n)); }
__device__ __forceinline__ float bflo(unsigned u) { return __uint_as_float(u << 16); }
__device__ __forceinline__ float bfhi(unsigned u) { return __uint_as_float(u & 0xffff0000u); }
__device__ __forceinline__ float bf2f(bf16_t b) { return __uint_as_float(((unsigned)b) << 16); }
__device__ __forceinline__ bf16_t f2bf(float f) { return (bf16_t)(cvt_pk_bf16(f, 0.f) & 0xffffu); }
__device__ __forceinline__ float fast_exp2(float x) { return __builtin_amdgcn_exp2f(x); }
__device__ __forceinline__ float sigmoidf_(float x) { return __builtin_amdgcn_rcpf(1.0f + __expf(-x)); }
__device__ __forceinline__ float gelu_tanh(float x) { const float z = 0.7978845608028654f * (x + 0.044715f * x * x * x); const float e = __expf(2.0f * z); const float t = 1.0f - 2.0f * __builtin_amdgcn_rcpf(e + 1.0f); return 0.5f * x * (1.0f + t); }
__device__ __forceinline__ float row_rstd(const float* ssq, int row) {
    const f32x4* p = (const f32x4*)(ssq + (size_t)row * 16); const f32x4 a = p[0], b = p[1], c = p[2], d = p[3];
    const float s = (((a.x + a.y) + (a.z + a.w)) + ((b.x + b.y) + (b.z + b.w))) + (((c.x + c.y) + (c.z + c.w)) + ((d.x + d.y) + (d.z + d.w)));
    return __builtin_amdgcn_rsqf(s * (1.0f / DM) + EPS);
}
__device__ __forceinline__ float wave_sum(float v) {
#pragma unroll
    for (int o = 1; o < 64; o <<= 1) v += __shfl_xor(v, o);
    return v;
}
#define LDS_WAIT() asm volatile("s_waitcnt lgkmcnt(0)" ::: "memory")
#define VM_WAIT() asm volatile("s_waitcnt vmcnt(0)" ::: "memory")

#define XB_TMO      128
#define XB_XCNT(j)  (256  + 64 * (j))
#define XB_XSUB(j)  (1280 + 64 * (j))
#define XB_XGEN(j)  (2304 + 64 * (j))
#define XB_TOP      3328
#define XB_TOPGEN   3392
#define XCD_BAR_WORDS 3456
#define XB_SPIN_CAP (1u << 22)
__device__ __forceinline__ unsigned xb_ld(unsigned* p)              { return __hip_atomic_load(p, __ATOMIC_RELAXED, __HIP_MEMORY_SCOPE_AGENT); }
__device__ __forceinline__ unsigned xb_add(unsigned* p, unsigned v) { return __hip_atomic_fetch_add(p, v, __ATOMIC_RELAXED, __HIP_MEMORY_SCOPE_AGENT); }
__device__ __forceinline__ unsigned xb_xcc_id() { return (unsigned)__builtin_amdgcn_s_getreg((3 << 11) | 20) & 0xFu; }
#define XB_SPIN(cond, bar) do { unsigned _sp = 0; while (cond) { __builtin_amdgcn_s_sleep(1); \
    if ((++_sp & 255u) == 0u) { if (xb_ld(&(bar)[XB_TMO])) break; if (_sp > XB_SPIN_CAP) { atomicAdd(&(bar)[XB_TMO], 1u); break; } } } } while (0)
struct XcdBarrier { unsigned* bar; unsigned x; volatile LAS unsigned* st; };
__device__ __forceinline__ XcdBarrier xcd_barrier_post(unsigned* bar, volatile LAS unsigned* st, int tid) {
    XcdBarrier b; b.bar = bar; b.x = xb_xcc_id(); b.st = st;
    if (tid == 0) (void)xb_add(&bar[XB_XCNT(b.x)], 1u);
    return b;
}
__device__ __forceinline__ void xcd_barrier_complete(unsigned* bar, unsigned x, unsigned& nloc, unsigned& nx) {
    const unsigned G = gridDim.x * gridDim.y * gridDim.z;
    unsigned sum, cnt, mine, sp = 0u;
    for (;;) {
        sum = 0u; cnt = 0u; mine = 0u;
#pragma unroll
        for (unsigned j = 0; j < 16; ++j) { const unsigned c = xb_ld(&bar[XB_XCNT(j)]); sum += c; cnt += (c > 0u) ? 1u : 0u; mine = (j == x) ? c : mine; }
        if (sum == G) break;
        __builtin_amdgcn_s_sleep(1);
        if ((++sp & 255u) == 0u) { if (xb_ld(&bar[XB_TMO])) break; if (sp > XB_SPIN_CAP) { atomicAdd(&bar[XB_TMO], 1u); break; } }
    }
    nloc = mine > 0u ? mine : 1u; nx = cnt > 0u ? cnt : 1u;
}
__device__ __forceinline__ void xcd_barrier(const XcdBarrier& b, int tid) {
    asm volatile("s_waitcnt vmcnt(0)" ::: "memory");
    __syncthreads();
    if (tid == 0) {
        unsigned* bar = b.bar;
        __builtin_amdgcn_s_waitcnt(0);
        unsigned nloc = b.st[0], nx = b.st[1];
        if (nloc == 0u) { xcd_barrier_complete(bar, b.x, nloc, nx); b.st[0] = nloc; b.st[1] = nx; }
        const unsigned old = xb_add(&bar[XB_XSUB(b.x)], 1u);
        const unsigned gen = old / nloc;
        if (old + 1u == (gen + 1u) * nloc) {
            __builtin_amdgcn_fence(__ATOMIC_RELEASE, "agent");
            asm volatile("s_waitcnt vmcnt(0)" ::: "memory");
            const unsigned og = xb_add(&bar[XB_TOP], 1u);
            const unsigned tg = og / nx;
            if (og + 1u == (tg + 1u) * nx) xb_add(&bar[XB_TOPGEN], 1u);
            else XB_SPIN(xb_ld(&bar[XB_TOPGEN]) == tg, bar);
            __builtin_amdgcn_fence(__ATOMIC_ACQUIRE, "agent");
            asm volatile("s_waitcnt vmcnt(0)" ::: "memory");
        } else {
            XB_SPIN(xb_ld(&bar[XB_TOPGEN]) == gen, bar);
            __builtin_amdgcn_fence(__ATOMIC_ACQUIRE, "agent");
            asm volatile("s_waitcnt vmcnt(0)" ::: "memory");
        }
    }
    __syncthreads();
}

namespace pg8 {
constexpr int BM = 256, BK = 64, HALF = 128, HTB = HALF * BK * 2, STAGE_BYTES = 8 * HTB, NXCD = 8, WGM = 8;
__host__ __device__ __forceinline__ int lds_byte(int r, int c) { const int st = (r >> 4) * 2 + (c >> 5), rr = r & 15, cc = c & 31, ob = rr * 64 + cc * 2; return st * 1024 + (ob ^ (((ob >> 9) & 1) << 5)); }
__host__ __device__ __forceinline__ void stage_rc(int b, int& R, int& C) { const int st = b / 1024, sb = b % 1024, swz = sb ^ (((sb >> 9) & 1) << 5); R = (st >> 1) * 16 + swz / 64; C = (st & 1) * 32 + (swz % 64) / 2; }
__host__ __device__ __forceinline__ int perm32(int rho) { const int n = rho >> 4, i = rho & 15; return 8 * (i >> 2) + 4 * n + (i & 3); }

struct Unit { unsigned a, b; const int* rows; int pm, pn, x0, x1, bd; };
struct Gemm { int lda, ldb, kstepA, kstepB, K, gmax, ksplit; };

struct DenseOrder {
    unsigned A, Bt, tA, tB; int nM, nN, nwg, G, c;
    __device__ void init(size_t A_, size_t Bt_, int M, int N, int lda, int ldb, int G_, int c_) { A = (unsigned)A_; Bt = (unsigned)Bt_; tA = (unsigned)BM * lda * 2; tB = (unsigned)BM * ldb * 2; nM = M / BM; nN = N / BM; nwg = nM * nN; G = G_; c = c_; }
    __device__ bool next(int i, Unit& u) const {
        const long L = (long)i * G + c; if (L >= nwg) return false;
        int wgid = (int)L; { const int q = nwg / NXCD, r = nwg % NXCD, xcd = wgid % NXCD, off = wgid / NXCD; wgid = (xcd < r ? xcd * (q + 1) : r * (q + 1) + (xcd - r) * q) + off; }
        const int nig = WGM * nN, gid = wgid / nig, fm = gid * WGM, gsz = (nM - fm) < WGM ? (nM - fm) : WGM;
        u.pm = fm + ((wgid % nig) % gsz); u.pn = (wgid % nig) / gsz; u.a = A + (unsigned)u.pm * tA; u.b = Bt + (unsigned)u.pn * tB; u.rows = nullptr; u.x0 = 0; u.x1 = 0; u.bd = 0; return true;
    }
};

template <class Epi, class Sched, bool GATHER>
__device__ __forceinline__ void gemm_phase(LAS unsigned char* lds, const unsigned char* wsbase, const Gemm g, const Sched& S, const Epi& E, int tid_) {
    const __amdgpu_buffer_rsrc_t rs = __builtin_amdgcn_make_buffer_rsrc((void*)wsbase, 0, 0xFFFFFFFFu, 0x00020000);
    const int tid = tid_, wid = __builtin_amdgcn_readfirstlane(tid >> 6), lane = tid & 63, wr = wid >> 2, wc = wid & 3, fr = lane & 15, fq = lane >> 4;
    const int K = g.K, nt = K / BK;
    unsigned voffB[2], cvA0[2], cvA1[2];
#pragma unroll
    for (int i = 0; i < 2; ++i) { int R, C; stage_rc(tid * 16 + i * 8192, R, C); const int Rb = Epi::PERM ? ((R & ~31) + perm32(R & 31)) : R;
        voffB[i] = (unsigned)(Rb * g.ldb + C) * 2u; }
    const unsigned kstepA = (unsigned)g.kstepA, kstepB = (unsigned)g.kstepB;
    const unsigned hstepA = (unsigned)HALF * g.lda * 2, hstepB = (unsigned)HALF * g.ldb * 2;
    const unsigned ldsw = (unsigned)wid * 1024u;
    const int aoff = lds_byte(wr * 64 + fr, fq * 8), boff = lds_byte(wc * 32 + fr, fq * 8);
#define PG8_SA(b, h) (((b) * 2 + (h)) * HTB)
#define PG8_SB(b, h) ((4 + (b) * 2 + (h)) * HTB)
#define PG8_STAGE(bufoff, gbase, voff) do { _Pragma("unroll") for (int _i = 0; _i < 2; ++_i) \
        __builtin_amdgcn_raw_ptr_buffer_load_lds(rs, (LAS void*)(lds + (bufoff) + ldsw + _i * 8192), 16, (int)(voff)[_i], (int)(gbase), 0, 0); } while (0)
#define PG8_LDA(dst, b, h) do { _Pragma("unroll") for (int m = 0; m < 4; ++m) _Pragma("unroll") for (int k = 0; k < 2; ++k) dst[m][k] = *(const LAS bf16x8*)(lds + PG8_SA(b, h) + aoff + m * 2048 + k * 1024); } while (0)
#define PG8_LDB(dst, b, h) do { _Pragma("unroll") for (int n = 0; n < 2; ++n) _Pragma("unroll") for (int k = 0; k < 2; ++k) dst[n][k] = *(const LAS bf16x8*)(lds + PG8_SB(b, h) + boff + n * 2048 + k * 1024); } while (0)
#define PG8_MMA(ai, bj, At, Bt) do { __builtin_amdgcn_s_setprio(1); _Pragma("unroll") for (int m = 0; m < 4; ++m) _Pragma("unroll") for (int n = 0; n < 2; ++n) _Pragma("unroll") for (int k = 0; k < 2; ++k) \
        acc[ai][bj][m][n] = __builtin_amdgcn_mfma_f32_16x16x32_bf16(Bt[n][k], At[m][k], acc[ai][bj][m][n], 0, 0, 0); __builtin_amdgcn_s_setprio(0); } while (0)
#define PG8_WAIT_V(n) asm volatile("s_waitcnt vmcnt(" #n ")" ::: "memory")
#define PG8_WAIT_L(n) asm volatile("s_waitcnt lgkmcnt(" #n ")" ::: "memory")
#define PG8_BAR __builtin_amdgcn_s_barrier()
#define PG8_SCHED __builtin_amdgcn_sched_barrier(0)
#define PG8_STAGE_A(bufoff, gbase, half) do { if (half) PG8_STAGE(bufoff, gbase, cvA1); else PG8_STAGE(bufoff, gbase, cvA0); } while (0)
#define PG8_AOFF(u, o0, o1) do { if (GATHER) { _Pragma("unroll") for (int _i = 0; _i < 2; ++_i) { int sR_, sC_; stage_rc(tid * 16 + _i * 8192, sR_, sC_); \
            unsigned r0 = (unsigned)(u).rows[sR_], r1 = (unsigned)(u).rows[HALF + sR_]; r0 = r0 <= (unsigned)g.gmax ? r0 : 0u; r1 = r1 <= (unsigned)g.gmax ? r1 : 0u; \
            o0[_i] = (r0 * (unsigned)g.lda + (unsigned)sC_) * 2u; o1[_i] = (r1 * (unsigned)g.lda + (unsigned)sC_) * 2u; } } \
        else { _Pragma("unroll") for (int _i = 0; _i < 2; ++_i) { int sR_, sC_; stage_rc(tid * 16 + _i * 8192, sR_, sC_); o0[_i] = (unsigned)(sR_ * g.lda + sC_) * 2u; o1[_i] = o0[_i] + (unsigned)hstepA; } } } while (0)
    Unit cur, nxt; int ui = 0;
    if (!S.next(0, cur)) return;
    f32x4 acc[2][2][4][2];
#pragma unroll
    for (int a = 0; a < 2; ++a)
#pragma unroll
        for (int b = 0; b < 2; ++b)
#pragma unroll
            for (int m = 0; m < 4; ++m)
#pragma unroll
                for (int n = 0; n < 2; ++n) acc[a][b][m][n] = (f32x4){0.f, 0.f, 0.f, 0.f};
    bf16x8 At[4][2], B0[2][2], B1[2][2];
    unsigned cA = cur.a, cB = cur.b;
    PG8_AOFF(cur, cvA0, cvA1);
    if (GATHER) { VM_WAIT(); }
    PG8_STAGE(PG8_SB(0, 0), cB, voffB); PG8_STAGE_A(PG8_SA(0, 0), cA, 0); PG8_STAGE(PG8_SB(0, 1), cB + hstepB, voffB); PG8_STAGE_A(PG8_SA(0, 1), cA, 1);
    if (wr == 1) PG8_BAR;
    PG8_WAIT_V(4); PG8_BAR;
    PG8_STAGE(PG8_SB(1, 0), cB + kstepB, voffB); PG8_STAGE_A(PG8_SA(1, 0), cA + kstepA, 0); PG8_STAGE(PG8_SB(1, 1), cB + hstepB + kstepB, voffB);
    PG8_WAIT_V(6); PG8_BAR;
    for (;;) {
        const bool has_next = S.next(ui + 1, nxt);
        const unsigned nA = has_next ? nxt.a : cA, nB = has_next ? nxt.b : cB;
        for (int t = 0; t < nt; t += 2) {
            const bool last = (t == nt - 2);
            unsigned nvA0[2], nvA1[2];
            if (GATHER) { if (last && has_next) { PG8_AOFF(nxt, nvA0, nvA1); VM_WAIT(); } }
            const unsigned a1 = cA + (unsigned)(t + 1) * kstepA;
            const unsigned a2 = last ? nA : cA + (unsigned)(t + 2) * kstepA, b2 = last ? nB : cB + (unsigned)(t + 2) * kstepB + ((t + 2) >= g.ksplit ? (unsigned)cur.bd : 0u);
            const unsigned a3 = a2 + kstepA, b3 = last ? nB + kstepB : cB + (unsigned)(t + 3) * kstepB + ((t + 3) >= g.ksplit ? (unsigned)cur.bd : 0u);
            PG8_LDB(B0, 0, 0); PG8_SCHED; PG8_LDA(At, 0, 0); PG8_STAGE_A(PG8_SA(1, 1), a1, 1);
            if (GATHER) { if (last && has_next) {
#pragma unroll
                for (int i = 0; i < 2; ++i) { cvA0[i] = nvA0[i]; cvA1[i] = nvA1[i]; } } }
            PG8_WAIT_L(8); PG8_BAR; PG8_WAIT_L(0); PG8_MMA(0, 0, At, B0); PG8_BAR; PG8_SCHED;
            PG8_LDB(B1, 0, 1); PG8_STAGE(PG8_SB(0, 0), b2, voffB);
            PG8_BAR; PG8_WAIT_L(0); PG8_MMA(0, 1, At, B1); PG8_BAR;
            PG8_LDA(At, 0, 1); PG8_STAGE_A(PG8_SA(0, 0), a2, 0);
            PG8_BAR; PG8_WAIT_L(0); PG8_MMA(1, 0, At, B0); PG8_BAR; PG8_SCHED;
            PG8_STAGE(PG8_SB(0, 1), b2 + hstepB, voffB);
            PG8_WAIT_V(6); PG8_BAR; PG8_MMA(1, 1, At, B1); PG8_BAR;
            PG8_LDB(B0, 1, 0); PG8_SCHED; PG8_LDA(At, 1, 0); PG8_STAGE_A(PG8_SA(0, 1), a2, 1);
            PG8_WAIT_L(8); PG8_BAR; PG8_WAIT_L(0); PG8_MMA(0, 0, At, B0); PG8_BAR; PG8_SCHED;
            PG8_LDB(B1, 1, 1); PG8_STAGE(PG8_SB(1, 0), b3, voffB);
            PG8_BAR; PG8_WAIT_L(0); PG8_MMA(0, 1, At, B1); PG8_BAR;
            PG8_LDA(At, 1, 1); PG8_STAGE_A(PG8_SA(1, 0), a3, 0);
            PG8_BAR; PG8_WAIT_L(0); PG8_MMA(1, 0, At, B0); PG8_BAR; PG8_SCHED;
            PG8_STAGE(PG8_SB(1, 1), b3 + hstepB, voffB);
            PG8_WAIT_V(6); PG8_BAR; PG8_MMA(1, 1, At, B1); PG8_BAR;
        }
        if constexpr (!Epi::AFTER_DRAIN) { E(acc, cur, wr, wc, fr, fq); }
        if (!has_next) break;
#pragma unroll
        for (int a = 0; a < 2; ++a)
#pragma unroll
            for (int b = 0; b < 2; ++b)
#pragma unroll
                for (int m = 0; m < 4; ++m)
#pragma unroll
                    for (int n = 0; n < 2; ++n) acc[a][b][m][n] = (f32x4){0.f, 0.f, 0.f, 0.f};
        cur = nxt; cA = nA; cB = nB; ++ui;
    }
    PG8_WAIT_V(0);
    if (wr == 0) PG8_BAR;
    PG8_BAR;
    if constexpr (Epi::AFTER_DRAIN) { E.fused(acc, cur, wr, wc, fr, fq, lds, wid, lane); }
#undef PG8_SA
#undef PG8_SB
#undef PG8_STAGE
#undef PG8_LDA
#undef PG8_LDB
#undef PG8_MMA
#undef PG8_WAIT_V
#undef PG8_WAIT_L
#undef PG8_BAR
#undef PG8_SCHED
#undef PG8_AOFF
#undef PG8_STAGE_A
}
}
using pg8::Unit;
typedef f32x4 AccT[2][2][4][2];

struct Args { const void* in[37]; float* out; unsigned char* ws; int ph_lo, ph_hi; };
#define GAS __attribute__((address_space(1)))
struct Frame {
    LAS unsigned char* lds; int tid, lane, wave, G, bx, z;
    GAS unsigned char* ws; GAS float* out; const void* const* in;
};
#define WSP(T, off) ((T*)(GAS T*)(F.ws + (off)))
#define INF(i) ((const float*)F.in[(i) + F.z])


struct EpiPlainBf16 {
    static constexpr bool PERM = true, AFTER_DRAIN = false;
    bf16_t* O0; bf16_t* O1;
    __device__ __forceinline__ void operator()(const AccT& acc, const Unit& u, int wr, int wc, int fr, int fq) const {
        const int ldc = u.x0 ? 2048 : 1024; bf16_t* base = (u.x0 ? O1 : O0) + (size_t)u.x1 * (2048 * 1024);
        const int row0 = u.pm * 256 + wr * 64 + fr, col0 = u.pn * 256 + wc * 32 + 8 * fq;
#pragma unroll
        for (int ai = 0; ai < 2; ++ai)
#pragma unroll
            for (int m = 0; m < 4; ++m) { bf16_t* rowp = base + (size_t)(row0 + ai * 128 + m * 16) * ldc + col0;
#pragma unroll
                for (int bj = 0; bj < 2; ++bj) { const f32x4 v0 = acc[ai][bj][m][0], v1 = acc[ai][bj][m][1];
                    u32x4 w; w.x = cvt_pk_bf16(v0[0], v0[1]); w.y = cvt_pk_bf16(v0[2], v0[3]); w.z = cvt_pk_bf16(v1[0], v1[1]); w.w = cvt_pk_bf16(v1[2], v1[3]);
                    *(u32x4*)(rowp + bj * 128) = w; } }
    }
};

struct EpiRowScale {
    static constexpr bool PERM = true, AFTER_DRAIN = false;
    bf16_t* O; int ldc; const float* ssq; const float* rope; int rope_pn;
    __device__ __forceinline__ void operator()(const AccT& acc, const Unit& u, int wr, int wc, int fr, int fq) const {
        const int row0 = u.pm * 256 + wr * 64 + fr, col0 = u.pn * 256 + wc * 32 + 8 * fq;
        const bool do_rope = (u.pn == rope_pn) && ((wc & 1) == 0);
        f32x4 qs[2][4];
#pragma unroll
        for (int ai = 0; ai < 2; ++ai)
#pragma unroll
            for (int m = 0; m < 4; ++m) qs[ai][m] = *(const f32x4*)((const char*)ssq + ((unsigned)(row0 + ai * 128 + m * 16) * 64u + (unsigned)fq * 16u));
        float rsv[2][4];
#pragma unroll
        for (int ai = 0; ai < 2; ++ai)
#pragma unroll
            for (int m = 0; m < 4; ++m) { const f32x4 q = qs[ai][m]; float sm = (q.x + q.y) + (q.z + q.w); sm += __shfl_xor(sm, 16); sm += __shfl_xor(sm, 32); rsv[ai][m] = __builtin_amdgcn_rsqf(sm * (1.0f / DM) + EPS); }
#pragma unroll
        for (int ai = 0; ai < 2; ++ai)
#pragma unroll
            for (int m = 0; m < 4; ++m) { const int row = row0 + ai * 128 + m * 16; const float rs = rsv[ai][m]; char* rowp = (char*)O + ((unsigned)row * (unsigned)ldc + (unsigned)col0) * 2u;
                f32x4 cs0 = {0.f, 0.f, 0.f, 0.f}, cs1 = cs0, sn0 = cs0, sn1 = cs0;
                if (do_rope) { const f32x4* rp = (const f32x4*)(rope + (size_t)row * 16); cs0 = rp[0]; cs1 = rp[1]; sn0 = rp[2]; sn1 = rp[3]; }
#pragma unroll
                for (int bj = 0; bj < 2; ++bj) { f32x4 v0 = acc[ai][bj][m][0] * rs, v1 = acc[ai][bj][m][1] * rs;
                    if (do_rope) {
                        f32x4 p0, p1;
#pragma unroll
                        for (int j = 0; j < 4; ++j) { p0[j] = __shfl_xor(v0[j], 16); p1[j] = __shfl_xor(v1[j], 16); }
                        if (fq == 0) { v0 = v0 * cs0 - p0 * sn0; v1 = v1 * cs1 - p1 * sn1; }
                        else if (fq == 1) { v0 = v0 * cs0 + p0 * sn0; v1 = v1 * cs1 + p1 * sn1; }
                    }
                    u32x4 w; w.x = cvt_pk_bf16(v0[0], v0[1]); w.y = cvt_pk_bf16(v0[2], v0[3]); w.z = cvt_pk_bf16(v1[0], v1[1]); w.w = cvt_pk_bf16(v1[2], v1[3]);
                    *(u32x4*)(rowp + bj * 256) = w; } }
    }
};

struct EpiColScale {
    static constexpr bool PERM = true, AFTER_DRAIN = false;
    bf16_t* O; const float* ssq;
    __device__ __forceinline__ void operator()(const AccT& acc, const Unit& u, int wr, int wc, int fr, int fq) const {
        const int row0 = u.pm * 256 + wr * 64 + fr, col0 = u.pn * 256 + wc * 32 + 8 * fq;
        const int ln = fr + 16 * fq; const float mine = row_rstd(ssq, u.pn * 256 + wc * 32 + (ln >> 5) * 128 + (ln & 31));
#pragma unroll
        for (int bj = 0; bj < 2; ++bj) { float rs[8];
#pragma unroll
            for (int j = 0; j < 8; ++j) rs[j] = __shfl(mine, bj * 32 + 8 * fq + j);
#pragma unroll
            for (int ai = 0; ai < 2; ++ai)
#pragma unroll
                for (int m = 0; m < 4; ++m) { const f32x4 v0 = acc[ai][bj][m][0], v1 = acc[ai][bj][m][1];
                    u32x4 w; w.x = cvt_pk_bf16(v0[0] * rs[0], v0[1] * rs[1]); w.y = cvt_pk_bf16(v0[2] * rs[2], v0[3] * rs[3]); w.z = cvt_pk_bf16(v1[0] * rs[4], v1[1] * rs[5]); w.w = cvt_pk_bf16(v1[2] * rs[6], v1[3] * rs[7]);
                    *(u32x4*)((char*)O + ((unsigned)(row0 + ai * 128 + m * 16) * (unsigned)NTOK + (unsigned)(col0 + bj * 128)) * 2u) = w; } }
    }
};

struct EpiResid {
    static constexpr bool PERM = true, AFTER_DRAIN = false;
    bf16_t* hb; float* ssq;
    __device__ __forceinline__ void operator()(const AccT& acc, const Unit& u, int wr, int wc, int fr, int fq) const {
        const int row0 = u.pm * 256 + wr * 64 + fr, col0 = u.pn * 256 + wc * 32 + 8 * fq;
        u32x4 bsa[2][4][2];
#pragma unroll
        for (int ai = 0; ai < 2; ++ai)
#pragma unroll
            for (int m = 0; m < 4; ++m) { const unsigned off = ((unsigned)(row0 + ai * 128 + m * 16) * DM + (unsigned)col0) * 2u;
#pragma unroll
                for (int bj = 0; bj < 2; ++bj) bsa[ai][m][bj] = *(const u32x4*)((const char*)hb + off + bj * 256); }
#pragma unroll
        for (int ai = 0; ai < 2; ++ai) {
#pragma unroll
            for (int m = 0; m < 4; ++m) { const int row = row0 + ai * 128 + m * 16; const unsigned off = ((unsigned)row * DM + (unsigned)col0) * 2u; float ss; f32x2 sp = {0.f, 0.f};
#pragma unroll
                for (int bj = 0; bj < 2; ++bj) { const f32x4 a0 = acc[ai][bj][m][0], a1 = acc[ai][bj][m][1]; const u32x4 b4 = bsa[ai][m][bj];
                    const float o0 = bflo(b4.x) + a0[0], o1 = bfhi(b4.x) + a0[1], o2 = bflo(b4.y) + a0[2], o3 = bfhi(b4.y) + a0[3], o4 = bflo(b4.z) + a1[0], o5 = bfhi(b4.z) + a1[1], o6 = bflo(b4.w) + a1[2], o7 = bfhi(b4.w) + a1[3];
                    u32x4 w; w.x = cvt_pk_bf16(o0, o1); w.y = cvt_pk_bf16(o2, o3); w.z = cvt_pk_bf16(o4, o5); w.w = cvt_pk_bf16(o6, o7); *(u32x4*)((char*)hb + off + bj * 256) = w;
                    const f32x2 p01 = {o0, o1}, p23 = {o2, o3}, p45 = {o4, o5}, p67 = {o6, o7}; sp = p01 * p01 + sp; sp = p23 * p23 + sp; sp = p45 * p45 + sp; sp = p67 * p67 + sp; }
                ss = sp.x + sp.y; ss += __shfl_xor(ss, 16); ss += __shfl_xor(ss, 32);
                if (fq == 0) *(float*)((char*)ssq + ((unsigned)row * 16u + (unsigned)(u.pn * 4 + wc)) * 4u) = ss; }
            asm volatile("" ::: "memory"); }
    }
};

struct EpiOddIn {
    static constexpr bool PERM = true, AFTER_DRAIN = false;
    bf16_t* Bg; bf16_t* CV; const float* ssq;
    __device__ __forceinline__ void operator()(const AccT& acc, const Unit& u, int wr, int wc, int fr, int fq) const {
        const int row0 = u.pm * 256 + wr * 64 + fr;
        f32x4 qs[2][4];
#pragma unroll
        for (int ai = 0; ai < 2; ++ai)
#pragma unroll
            for (int m = 0; m < 4; ++m) qs[ai][m] = *(const f32x4*)((const char*)ssq + ((unsigned)(row0 + ai * 128 + m * 16) * 64u + (unsigned)fq * 16u));
        float rsv[2][4];
#pragma unroll
        for (int ai = 0; ai < 2; ++ai)
#pragma unroll
            for (int m = 0; m < 4; ++m) { const f32x4 q = qs[ai][m]; float sm = (q.x + q.y) + (q.z + q.w); sm += __shfl_xor(sm, 16); sm += __shfl_xor(sm, 32); rsv[ai][m] = __builtin_amdgcn_rsqf(sm * (1.0f / DM) + EPS); }
#pragma unroll
        for (int ai = 0; ai < 2; ++ai)
#pragma unroll
            for (int m = 0; m < 4; ++m) { const int row = row0 + ai * 128 + m * 16; const float rs = rsv[ai][m];
                if (u.pn < 8) { const float r2 = rs * rs; const f32x4 o0 = acc[ai][0][m][0] * acc[ai][1][m][0] * r2, o1 = acc[ai][0][m][1] * acc[ai][1][m][1] * r2;
                    u32x4 w; w.x = cvt_pk_bf16(o0[0], o0[1]); w.y = cvt_pk_bf16(o0[2], o0[3]); w.z = cvt_pk_bf16(o1[0], o1[1]); w.w = cvt_pk_bf16(o1[2], o1[3]);
                    *(u32x4*)((char*)CV + ((unsigned)row * DM + (unsigned)(u.pn * 128 + wc * 32 + 8 * fq)) * 2u) = w;
                } else {
#pragma unroll
                    for (int bj = 0; bj < 2; ++bj) { const f32x4 o0 = acc[ai][bj][m][0] * rs, o1 = acc[ai][bj][m][1] * rs;
                        u32x4 w; w.x = cvt_pk_bf16(o0[0], o0[1]); w.y = cvt_pk_bf16(o0[2], o0[3]); w.z = cvt_pk_bf16(o1[0], o1[1]); w.w = cvt_pk_bf16(o1[2], o1[3]);
                        *(u32x4*)((char*)Bg + ((unsigned)row * DM + (unsigned)((u.pn - 8) * 256 + bj * 128 + wc * 32 + 8 * fq)) * 2u) = w; }
                } }
    }
};

struct EpiGateUp {
    static constexpr bool PERM = true, AFTER_DRAIN = false;
    bf16_t* hmid; const float* ssq; const float* rw;
    __device__ __forceinline__ void operator()(const AccT& acc, const Unit& u, int wr, int wc, int fr, int fq) const {
        int tok[2][4]; float rs[2][4], wg[2][4];
#pragma unroll
        for (int ai = 0; ai < 2; ++ai)
#pragma unroll
            for (int m = 0; m < 4; ++m) { const int r = ai * 128 + wr * 64 + m * 16 + fr; tok[ai][m] = (r < u.x0) ? u.rows[r] : -1; }
#pragma unroll
        for (int ai = 0; ai < 2; ++ai)
#pragma unroll
            for (int m = 0; m < 4; ++m) { const unsigned t = tok[ai][m] >= 0 ? (unsigned)tok[ai][m] : 0u; rs[ai][m] = *(const float*)((const char*)ssq + t * 4u); wg[ai][m] = *(const float*)((const char*)rw + (t * 2u + (unsigned)u.pm) * 4u); }
#pragma unroll
        for (int ai = 0; ai < 2; ++ai)
#pragma unroll
            for (int m = 0; m < 4; ++m) { const int r = ai * 128 + wr * 64 + m * 16 + fr;
                if (tok[ai][m] >= 0) { const float rsv = rs[ai][m], k1 = rsv * rsv * wg[ai][m], k2 = -1.4426950408889634f * rsv;
                    float o[8];
#pragma unroll
                    for (int n = 0; n < 2; ++n) { const f32x4 g4 = acc[ai][0][m][n]; const f32x4 gu = g4 * acc[ai][1][m][n] * k1, t4 = g4 * k2;
#pragma unroll
                        for (int j = 0; j < 4; ++j) o[4 * n + j] = gu[j] * __builtin_amdgcn_rcpf(1.0f + fast_exp2(t4[j])); }
                    u32x4 w; w.x = cvt_pk_bf16(o[0], o[1]); w.y = cvt_pk_bf16(o[2], o[3]); w.z = cvt_pk_bf16(o[4], o[5]); w.w = cvt_pk_bf16(o[6], o[7]);
                    *(u32x4*)((char*)hmid + ((unsigned)(u.x1 + r) * 1024u + (unsigned)(u.pm * 512 + u.pn * 128 + wc * 32 + 8 * fq)) * 2u) = w; } }
    }
};

template <bool FINAL> struct EpiDown {
    static constexpr bool PERM = true, AFTER_DRAIN = false;
    bf16_t* hb; float* ssq; const float* rw; int pass;
    __device__ __forceinline__ void operator()(const AccT& acc, const Unit& u, int wr, int wc, int fr, int fq) const {
        const int col0 = u.pn * 256 + wc * 32 + 8 * fq;
        int tok[2][4];
#pragma unroll
        for (int ai = 0; ai < 2; ++ai)
#pragma unroll
            for (int m = 0; m < 4; ++m) { const int r = ai * 128 + wr * 64 + m * 16 + fr; tok[ai][m] = (r < u.x0) ? u.rows[r] : -1; }
#pragma unroll
        for (int ai = 0; ai < 2; ++ai) {
        u32x4 bs[4][2];
#pragma unroll
            for (int m = 0; m < 4; ++m) { const bool valid = tok[ai][m] >= 0; const unsigned off = ((unsigned)(valid ? tok[ai][m] : 0) * DM + (unsigned)col0) * 2u;
#pragma unroll
                for (int bj = 0; bj < 2; ++bj) bs[m][bj] = valid ? *(const u32x4*)((const char*)hb + off + bj * 256) : (u32x4){0u, 0u, 0u, 0u}; }
#pragma unroll
            for (int m = 0; m < 4; ++m) { const bool valid = tok[ai][m] >= 0; const unsigned off = ((unsigned)(valid ? tok[ai][m] : 0) * DM + (unsigned)col0) * 2u; float ss = 0.f;
                if (valid) {
#pragma unroll
                    for (int bj = 0; bj < 2; ++bj) { const f32x4 a0 = acc[ai][bj][m][0], a1 = acc[ai][bj][m][1]; const u32x4 b4 = bs[m][bj];
                        const float o0 = bflo(b4.x) + a0[0], o1 = bfhi(b4.x) + a0[1], o2 = bflo(b4.y) + a0[2], o3 = bfhi(b4.y) + a0[3], o4 = bflo(b4.z) + a1[0], o5 = bfhi(b4.z) + a1[1], o6 = bflo(b4.w) + a1[2], o7 = bfhi(b4.w) + a1[3];
                        u32x4 w; w.x = cvt_pk_bf16(o0, o1); w.y = cvt_pk_bf16(o2, o3); w.z = cvt_pk_bf16(o4, o5); w.w = cvt_pk_bf16(o6, o7); *(u32x4*)((char*)hb + off + bj * 256) = w;
                        if (FINAL) { const f32x2 p01 = {o0, o1}, p23 = {o2, o3}, p45 = {o4, o5}, p67 = {o6, o7}; f32x2 sp = p01 * p01; sp = p23 * p23 + sp; sp = p45 * p45 + sp; sp = p67 * p67 + sp; ss += sp.x + sp.y; } }
                }
                if (FINAL) { ss += __shfl_xor(ss, 16); ss += __shfl_xor(ss, 32); if (valid && fq == 0) *(float*)((char*)ssq + ((unsigned)tok[ai][m] * 16u + (unsigned)(u.pn * 4 + wc)) * 4u) = ss; } }
            asm volatile("" ::: "memory"); }
    }
};

struct Job { const float* src; int ld, K, ncols; const float* gain; bf16_t* dst; int ldd; };
__device__ __forceinline__ void transpose_item(const Job& J, LAS float* scr, int item, int lane) {
    const int nblk = (J.ncols + 31) / 32, kb = item / nblk, nb = item % nblk, k0 = 64 * kb, n0 = 32 * nb;
    const int nn = lane & 31; const bool nv = (n0 + nn) < J.ncols;
#pragma unroll 8
    for (int i = 0; i < 32; ++i) { const int kk = 2 * i + (lane >> 5); float v = nv ? J.src[(size_t)(k0 + kk) * J.ld + n0 + nn] : 0.f; if (J.gain) v *= J.gain[k0 + kk]; scr[kk * 33 + nn] = v; }
    LDS_WAIT(); asm volatile("" ::: "memory");
    const int c = lane & 7;
#pragma unroll
    for (int j = 0; j < 4; ++j) { const int n = (lane >> 3) + 8 * j; const LAS float* s = scr + (8 * c) * 33 + n;
        u32x4 o; o.x = cvt_pk_bf16(s[0 * 33], s[1 * 33]); o.y = cvt_pk_bf16(s[2 * 33], s[3 * 33]); o.z = cvt_pk_bf16(s[4 * 33], s[5 * 33]); o.w = cvt_pk_bf16(s[6 * 33], s[7 * 33]);
        if (n0 + n < J.ncols) *(u32x4*)(J.dst + (size_t)(n0 + n) * J.ldd + k0 + 8 * c) = o; }
    LDS_WAIT(); asm volatile("" ::: "memory");
}
__device__ __forceinline__ bool job_wide(const Job& J) { return ((J.ncols & 63) == 0) && ((J.K & 63) == 0); }
__device__ __forceinline__ int job_items(const Job& J) { return job_wide(J) ? (J.K >> 6) * (J.ncols >> 6) : (J.K / 64) * ((J.ncols + 31) / 32); }
__device__ __forceinline__ void transpose_item64(const Job& J, LAS float* scr, int item, int lane) {
    const int nblk = J.ncols >> 6, kb = item / nblk, nb = item - kb * nblk, k0 = 64 * kb, n0 = 64 * nb;
    const int r4 = lane >> 4, c4 = lane & 15;
    f32x4 v[16];
#pragma unroll
    for (int i = 0; i < 16; ++i) v[i] = *(const f32x4*)(J.src + (size_t)(k0 + 4 * i + r4) * J.ld + n0 + 4 * c4);
    if (J.gain) {
#pragma unroll
        for (int i = 0; i < 16; ++i) v[i] *= J.gain[k0 + 4 * i + r4]; }
#pragma unroll
    for (int i = 0; i < 16; ++i) { const int kk = 4 * i + r4;
#pragma unroll
        for (int j = 0; j < 4; ++j) scr[(4 * c4 + j) * 65 + kk] = v[i][j]; }
    LDS_WAIT(); asm volatile("" ::: "memory");
    const int c = lane & 7;
#pragma unroll
    for (int j = 0; j < 8; ++j) { const int n = (lane >> 3) + 8 * j; const LAS float* sp = scr + n * 65 + 8 * c;
        u32x4 o; o.x = cvt_pk_bf16(sp[0], sp[1]); o.y = cvt_pk_bf16(sp[2], sp[3]); o.z = cvt_pk_bf16(sp[4], sp[5]); o.w = cvt_pk_bf16(sp[6], sp[7]);
        *(u32x4*)(J.dst + (size_t)(n0 + n) * J.ldd + k0 + 8 * c) = o; }
    LDS_WAIT(); asm volatile("" ::: "memory");
}
__device__ __forceinline__ void run_item(const Job& J, LAS float* scr, int item, int lane) { if (job_wide(J)) transpose_item64(J, scr, item, lane); else transpose_item(J, scr, item, lane); }
__device__ __forceinline__ void run_job(Frame& F, const Job& J, int& base) {
    LAS float* scr = (LAS float*)(F.lds + F.wave * 16640);
    const int gw = F.bx * 8 + F.wave, NGW = F.G * 8;
    const int nitems = job_items(J);
    int first = gw - base % NGW; if (first < 0) first += NGW;
    for (int it = first; it < nitems; it += NGW) run_item(J, scr, it, F.lane);
    base += nitems;
}
constexpr int NJOBS_P0 = 118;
__device__ __forceinline__ void p0_job(Frame& F, int j, Job& J) {
    J.gain = nullptr; J.ld = DM; J.K = DM; J.ncols = DM; J.ldd = DM;
    if (j < 54) { const int e = j / 27, q = j % 27; const float* win = INF(8) + (size_t)e * DM * EPROJ; const float* gmix = INF(3) + (size_t)(2 * e) * DM;
        bf16_t* wa = WSP(bf16_t, WS_W_EINA) + (size_t)e * PA_N * DM; bf16_t* wb = WSP(bf16_t, WS_W_EINB) + (size_t)e * PB_N * DM;
        if (q < 6) { J.ld = EPROJ; J.gain = gmix;
            const int sc = q == 0 ? 0 : q == 1 ? 1792 : q == 2 ? 2048 : q == 3 ? 1920 : q == 4 ? 2176 : 2304;
            const int nc = q == 0 ? 1792 : q == 5 ? 24 : 128;
            const int dr = q == 0 ? 0 : q == 1 ? 1792 : q == 2 ? 1920 : q == 3 ? 0 : q == 4 ? 128 : 256;
            J.src = win + sc; J.ncols = nc; J.dst = (q < 3 ? wa : wb) + (size_t)dr * DM; }
        else if (q == 6) { J.src = INF(9) + (size_t)e * DM * DM; J.dst = WSP(bf16_t, WS_W_EOUT) + (size_t)e * DM * DM; }
        else if (q < 23) { const int ri = (q - 7) / 8, k = (q - 7) % 8; J.src = INF(ri ? 14 : 12) + (size_t)(e * 8 + k) * 4096; J.ld = 64; J.K = 64; J.ncols = 64; J.ldd = 64;
            J.dst = WSP(bf16_t, WS_W_LRU) + (size_t)((e * 2 + ri) * 8 + k) * 4096; }
        else { const int kv = (q - 23) / 2, hf = (q - 23) % 2; J.src = INF(kv ? 21 : 18) + (size_t)e * 2048 * 128 + (size_t)hf * 1024 * 128; J.ld = 128; J.K = 1024; J.ncols = 128; J.ldd = 1024;
            J.dst = WSP(bf16_t, WS_W_CMP1) + (size_t)((e * 2 + kv) * 256 + hf * 128) * 1024; }
    } else if (j < 90) { const int o = (j - 54) / 18, q = (j - 54) % 18; const float* win = INF(23) + (size_t)o * DM * 3072; bf16_t* wo = WSP(bf16_t, WS_W_OIN) + (size_t)o * 3072 * DM;
        J.gain = INF(3) + (size_t)(2 * o + 1) * DM; J.ld = 3072;
        if (q < 8) { J.src = win + 1024 + 128 * q; J.ncols = 128; J.dst = wo + (size_t)(256 * q) * DM; }
        else if (q < 16) { J.src = win + 2048 + 128 * (q - 8); J.ncols = 128; J.dst = wo + (size_t)(256 * (q - 8) + 128) * DM; }
        else if (q == 16) { J.src = win; J.ncols = 1024; J.dst = wo + (size_t)2048 * DM; }
        else { J.gain = nullptr; J.ld = DM; J.src = INF(25) + (size_t)o * DM * DM; J.dst = WSP(bf16_t, WS_W_OOUT) + (size_t)o * DM * DM; }
    } else if (j < 114) { const int l = (j - 90) / 6, q = (j - 90) % 6; const size_t lo = (size_t)l * DM * DM;
        if (q == 0) { J.src = INF(26) + lo; J.gain = INF(4) + l * DM; J.dst = WSP(bf16_t, WS_W_XQ) + lo; }
        else if (q == 1) { J.src = INF(27) + lo; J.gain = INF(5) + l * DM; J.dst = WSP(bf16_t, WS_W_XK) + lo; }
        else if (q == 2) { J.src = INF(28) + lo; J.gain = INF(5) + l * DM; J.dst = WSP(bf16_t, WS_W_XV) + lo; }
        else if (q == 3) { J.src = INF(29) + lo; J.dst = WSP(bf16_t, WS_W_XO) + lo; }
        else if (q == 4) { J.src = INF(30) + (size_t)l * DM * 4; J.ld = 4; J.ncols = 4; J.gain = INF(6) + l * DM; J.dst = WSP(bf16_t, WS_W_RT) + (size_t)l * 32 * DM; }
        else { J.src = INF(32) + (size_t)l * DM * 16; J.ld = 16; J.ncols = 16; J.gain = INF(6) + l * DM; J.dst = WSP(bf16_t, WS_W_RT) + (size_t)(l * 32 + 4) * DM; }
    } else { const int q = j - 114, e = q / 2, kv = q % 2; J.src = INF(kv ? 22 : 19) + (size_t)e * 128 * 64; J.ld = 64; J.K = 128; J.ncols = 64; J.ldd = 128;
        J.dst = WSP(bf16_t, WS_W_CMP2) + (size_t)(e * 2 + kv) * 64 * 128; }
}
__device__ __forceinline__ void moe_job(Frame& F, int l, int j, Job& J) {
    const int e = j / 9, q = j % 9; const size_t eo = (size_t)(l * 16 + e) * DM * 512;
    if (q < 8) { const int pn = q & 3, up = q >> 2; J.src = INF(up ? 35 : 34) + eo + 128 * pn; J.ld = 512; J.K = DM; J.ncols = 128; J.gain = INF(6) + l * DM; J.ldd = DM;
        J.dst = (bf16_t*)(F.ws + ((l & 1) ? WS_MOE_GU2 : WS_MOE_GU)) + (size_t)e * DM * DM + (size_t)(256 * pn + 128 * up) * DM; }
    else { J.src = INF(36) + eo; J.ld = DM; J.K = 512; J.ncols = DM; J.gain = nullptr; J.ldd = 512; J.dst = (bf16_t*)(F.ws + ((l & 1) ? WS_MOE_D2 : WS_MOE_D)) + (size_t)e * DM * 512; }
}

constexpr int MOE_ITEMS = 16 * 384;
__device__ __forceinline__ void moe_convert_drain(Frame& F, int layer) {
    if (layer >= DEPTH) return;
    LAS int* qs = (LAS int*)(F.lds + LDS_MISC + 1024);
    LAS float* scr = (LAS float*)(F.lds + F.wave * 16640);
    unsigned* qh = WSP(unsigned, WS_CTL) + CW_Q + layer * 16;
    for (;;) {
        if (F.tid == 0) qs[0] = (int)atomicAdd(qh, 32u);
        __syncthreads();
        const int base = qs[0];
        __syncthreads();
        if (base >= MOE_ITEMS) break;
#pragma unroll 1
        for (int k = 0; k < 4; ++k) { const int idx = base + F.wave * 4 + k; if (idx >= MOE_ITEMS) break;
            const int e = idx / 384, r = idx - e * 384; const int q = r < 256 ? (r >> 5) : 8, item = r < 256 ? (r & 31) : (r - 256);
            Job J; moe_job(F, layer, e * 9 + q, J); transpose_item64(J, scr, item, F.lane); }
    }
}

__device__ __forceinline__ void phase_prologue(Frame& F) {
    const int gw = F.bx * 8 + F.wave, NGW = F.G * 8, gt = F.bx * 512 + F.tid, NGT = F.G * 512;
    { int base = 0; for (int j = 0; j < NJOBS_P0; ++j) { Job J; p0_job(F, j, J); run_job(F, J, base); } }
    for (int i = gt; i < 2 * 232 * (DM / 8); i += NGT) { const int e = i / (232 * 128), r = (i / 128) % 232, c = i % 128; *(u32x4*)(WSP(bf16_t, WS_W_EINB) + ((size_t)e * PB_N + 280 + r) * DM + c * 8) = (u32x4){0u, 0u, 0u, 0u}; }
    for (int i = gt; i < 4 * 12 * (DM / 8); i += NGT) { const int l = i / (12 * 128), r = (i / 128) % 12, c = i % 128; *(u32x4*)(WSP(bf16_t, WS_W_RT) + ((size_t)l * 32 + 20 + r) * DM + c * 8) = (u32x4){0u, 0u, 0u, 0u}; }
    { const int* pos = (const int*)F.in[2 + F.z]; float* rope = WSP(float, WS_ROPE);
      for (int i = gt; i < NTOK * 8; i += NGT) { const int tok = i >> 3, k = i & 7;
          const double invrev = k == 0 ? 0.15915494309189535 : k == 1 ? 0.03086376340470123 : k == 2 ? 0.005985185712713705 : k == 3 ? 0.001160663641240061 :
                                k == 4 ? 0.00022507907903927653 : k == 5 ? 4.364795279280289e-05 : k == 6 ? 8.464330808241401e-06 : 1.6414262627950345e-06;
          const double rev = (double)pos[tok] * invrev; const float fr = (float)(rev - __builtin_rint(rev));
          rope[(size_t)tok * 16 + k] = __builtin_amdgcn_cosf(fr); rope[(size_t)tok * 16 + 8 + k] = __builtin_amdgcn_sinf(fr); } }
    for (int m = gw; m < NTOK + NB * MEMLEN; m += NGW) {
        const bool isx = m < NTOK; const int r = isx ? m : m - NTOK;
        const f32x4* xr = (const f32x4*)((isx ? INF(0) : INF(1)) + (size_t)r * DM) + F.lane; f32x4 v[4]; float s = 0.f;
#pragma unroll
        for (int j = 0; j < 4; ++j) { v[j] = xr[64 * j]; s += (v[j].x * v[j].x + v[j].y * v[j].y) + (v[j].z * v[j].z + v[j].w * v[j].w); }
        s = wave_sum(s); const float sc = isx ? 1.0f : 1.0f / sqrtf(s * (1.0f / DM) + EPS);
        u32x2* o8 = (u32x2*)((isx ? WSP(bf16_t, WS_HB) : WSP(bf16_t, WS_MNHAT)) + (size_t)r * DM) + F.lane;
#pragma unroll
        for (int j = 0; j < 4; ++j) { u32x2 w; w.x = cvt_pk_bf16(v[j].x * sc, v[j].y * sc); w.y = cvt_pk_bf16(v[j].z * sc, v[j].w * sc); o8[64 * j] = w; }
        if (isx && F.lane < 16) WSP(float, WS_SSQ)[(size_t)r * 16 + F.lane] = F.lane == 0 ? s : 0.f;
    }
    for (int o = gw; o < 2 * 2 * 128; o += NGW) { const int e = o >> 8, kv = (o >> 7) & 1, c = o & 127; const float* pos = INF(kv ? 20 : 17) + (size_t)e * 2048; const float* w1 = INF(kv ? 21 : 18) + (size_t)e * 2048 * 128;
        float s = 0.f; for (int kk = F.lane; kk < 2048; kk += 64) s += pos[kk] * w1[(size_t)kk * 128 + c];
        s = wave_sum(s); if (F.lane == 0) ((float*)(F.ws + WS_W_CMP2 + 512 * 1024))[o] = s; }
}

struct KvOrder {
    unsigned mn, wk, wv; int G, c;
    __device__ bool next(int i, Unit& u) const { const int L = i * G + c; if (L >= 256) return false; const int l = L >> 6, q = L & 63; u.rows = nullptr; u.x1 = l; u.bd = 0;
        if (q < 32) { u.pm = q >> 2; u.pn = q & 3; u.x0 = 0; u.a = mn + (unsigned)u.pm * 256 * DM * 2; u.b = wk + (unsigned)(l * DM + u.pn * 256) * DM * 2; }
        else { const int q2 = q - 32; u.pm = q2 >> 3; u.pn = q2 & 7; u.x0 = 1; u.a = wv + (unsigned)(l * DM + u.pm * 256) * DM * 2; u.b = mn + (unsigned)u.pn * 256 * DM * 2; }
        return true; }
};

__device__ __forceinline__ f32x16 mfma32(bf16x8 a, bf16x8 b, f32x16 c) { return __builtin_amdgcn_mfma_f32_32x32x16_bf16(a, b, c, 0, 0, 0); }
__device__ __forceinline__ f32x16 zero16() { f32x16 z; for (int i = 0; i < 16; ++i) z[i] = 0.f; return z; }
__device__ __forceinline__ bf16x8 pack8(float a, float b, float c, float d, float e, float f, float g, float h) { u32x4 t; t.x = cvt_pk_bf16(a, b); t.y = cvt_pk_bf16(c, d); t.z = cvt_pk_bf16(e, f); t.w = cvt_pk_bf16(g, h); return __builtin_bit_cast(bf16x8, t); }
__device__ __forceinline__ float xchg32(float v, int hh) { const unsigned u = __float_as_uint(v); const auto r = __builtin_amdgcn_permlane32_swap(u, u, false, false); return __uint_as_float(hh ? r[0] : r[1]); }
__device__ __forceinline__ bf16x8 join8(u32x2 lo, u32x2 hi) { u32x4 t; t.x = lo.x; t.y = lo.y; t.z = hi.x; t.w = hi.y; return __builtin_bit_cast(bf16x8, t); }

constexpr int LRU_XA = 0, LRU_XC = 8576, LRU_WAVE = 17792;
template <bool FINAL>
__device__ __forceinline__ void lru_unit(Frame& F, int e, int b, int tc) {
    const int w = F.wave, lane = F.lane, l31 = lane & 31, hh = lane >> 5;
    const bf16_t* proj = WSP(bf16_t, WS_RA);
    const size_t row0 = (size_t)b * SEQ + (size_t)tc * 64;
    LAS unsigned char* xa = F.lds + w * LRU_WAVE + LRU_XA; LAS unsigned char* xt = F.lds + w * LRU_WAVE + LRU_XC;
    const int lr = lane >> 3, lc = lane & 7;
    u32x4 xr[9], gr[8];
#pragma unroll
    for (int i = 0; i < 9; ++i) { const int rr = i * 8 + lr; const bool ok = (rr < 67) && (tc > 0 || rr >= 3);
        xr[i] = ok ? *(const u32x4*)(proj + (row0 + rr - 3) * PA_N + w * 64 + lc * 8) : (u32x4){0u, 0u, 0u, 0u}; }
    if (FINAL) {
#pragma unroll
        for (int i = 0; i < 8; ++i) gr[i] = *(const u32x4*)(proj + (row0 + i * 8 + lr) * PA_N + 512 + w * 64 + lc * 8);
    }
#pragma unroll
    for (int i = 0; i < 9; ++i) { const int rr = i * 8 + lr; if (rr < 67) *(LAS u32x4*)(xa + rr * 128 + lc * 16) = xr[i]; }
    {
        const int ch = w * 64 + lane; const float* cw = INF(10) + (size_t)e * 4 * 512; const float cb = INF(11)[e * 512 + ch];
        const float w0 = cw[ch], w1 = cw[512 + ch], w2 = cw[1024 + ch], w3 = cw[1536 + ch];
        float x0 = bf2f(*(const LAS bf16_t*)(xa + 0 * 128 + lane * 2)), x1 = bf2f(*(const LAS bf16_t*)(xa + 1 * 128 + lane * 2)), x2 = bf2f(*(const LAS bf16_t*)(xa + 2 * 128 + lane * 2));
#pragma unroll 16
        for (int t = 0; t < 64; ++t) { const float xn = bf2f(*(const LAS bf16_t*)(xa + (t + 3) * 128 + lane * 2)); const float xc = cb + w0 * x0 + w1 * x1 + w2 * x2 + w3 * xn;
            *(LAS bf16_t*)(xt + t * 144 + lane * 2) = f2bf(xc); x0 = x1; x1 = x2; x2 = xn; }
    }
    if (FINAL) {
#pragma unroll
        for (int i = 0; i < 8; ++i) *(LAS u32x4*)(xa + (i * 8 + lr) * 128 + lc * 16) = gr[i];
    }
    LDS_WAIT(); asm volatile("" ::: "memory");
    const bf16_t* wrT = WSP(bf16_t, WS_W_LRU) + (size_t)((e * 2 + 0) * 8 + w) * 4096;
    const bf16_t* wiT = WSP(bf16_t, WS_W_LRU) + (size_t)((e * 2 + 1) * 8 + w) * 4096;
    float* agg = WSP(float, WS_LRUAGG);
#pragma unroll 1
    for (int nb = 0; nb < 2; ++nb) {
        const int cl = nb * 32 + l31, chn = w * 64 + cl;
        bf16x8 br[4], bi[4];
#pragma unroll
        for (int s = 0; s < 4; ++s) { br[s] = *(const bf16x8*)(wrT + cl * 64 + 16 * s + 8 * hh); bi[s] = *(const bf16x8*)(wiT + cl * 64 + 16 * s + 8 * hh); }
        const float brs = INF(13)[e * 512 + chn], bis = INF(15)[e * 512 + chn], sp = log1pf(expf(-INF(16)[e * 512 + chn]));
        float carry = 0.f, atot = 1.f;
        if (FINAL) {
            const f32x2* ap = (const f32x2*)(agg + ((size_t)(b * 64) * 512 + chn) * 2);
            int p = 0;
            for (; p + 16 <= tc; p += 16) { f32x2 ah[16];
#pragma unroll
                for (int k = 0; k < 16; ++k) ah[k] = ap[(size_t)(p + k) * 512];
#pragma unroll
                for (int k = 0; k < 16; ++k) carry = ah[k].x * carry + ah[k].y; }
            for (; p < tc; ++p) { const f32x2 ah = ap[(size_t)p * 512]; carry = ah.x * carry + ah.y; }
        }
#pragma unroll 1
        for (int mb = 0; mb < 2; ++mb) {
            f32x16 ar = zero16(), ai = zero16();
#pragma unroll
            for (int s = 0; s < 4; ++s) { const bf16x8 a = *(const LAS bf16x8*)(xt + (mb * 32 + l31) * 144 + (16 * s + 8 * hh) * 2); ar = mfma32(a, br[s], ar); ai = mfma32(a, bi[s], ai); }
            float av[16], uv[16];
#pragma unroll
            for (int r = 0; r < 16; ++r) { const int t = mb * 32 + (r & 3) + 8 * (r >> 2) + 4 * hh; const float xc = bf2f(*(const LAS bf16_t*)(xt + t * 144 + cl * 2));
                const float rg = sigmoidf_(ar[r] + brs), ig = sigmoidf_(ai[r] + bis); const float la = -8.0f * rg * sp;
                const float a = __expf(la); av[r] = a; uv[r] = __builtin_amdgcn_sqrtf(fmaxf(1.0f - a * a, 0.f)) * (ig * xc); }
            float A[4], H[4], pA[4], pH[4], st[4];
#pragma unroll
            for (int q = 0; q < 4; ++q) { float Aq = 1.f, Hq = 0.f;
#pragma unroll
                for (int i = 0; i < 4; ++i) { Hq = av[4 * q + i] * Hq + uv[4 * q + i]; Aq *= av[4 * q + i]; }
                A[q] = Aq; H[q] = Hq; pA[q] = __shfl_xor(Aq, 32); pH[q] = __shfl_xor(Hq, 32); }
#pragma unroll
            for (int q = 0; q < 4; ++q) { const float A0 = hh ? pA[q] : A[q], H0 = hh ? pH[q] : H[q], A1 = hh ? A[q] : pA[q], H1 = hh ? H[q] : pH[q];
                const float s0 = carry; carry = A0 * carry + H0; const float s1 = carry; carry = A1 * carry + H1; st[q] = hh ? s1 : s0; atot *= A0 * A1; }
            if (FINAL) {
                const int par = l31 & 1; LAS unsigned char* gbase = xa + (mb * 32 + 4 * hh) * 128 + (cl & ~1) * 2;
                unsigned gw[16];
#pragma unroll
                for (int r = 0; r < 16; ++r) gw[r] = *(const LAS unsigned*)(gbase + ((r & 3) + 8 * (r >> 2)) * 128);
                float pr[16];
#pragma unroll
                for (int q = 0; q < 4; ++q) { float hc = st[q];
#pragma unroll
                    for (int i = 0; i < 4; ++i) { const int r = 4 * q + i; hc = av[r] * hc + uv[r];
                        const float gv = __uint_as_float((gw[r] >> (16 * par)) << 16); pr[r] = hc * gelu_tanh(gv); } }
                const unsigned psel = par ? 0x03020706u : 0x05040100u;
#pragma unroll
                for (int k = 0; k < 8; ++k) { const unsigned pm = cvt_pk_bf16(pr[2 * k], pr[2 * k + 1]);
                    const unsigned pn = (unsigned)__builtin_amdgcn_mov_dpp((int)pm, 0xB1, 0xF, 0xF, true);
                    const unsigned ow = __builtin_amdgcn_perm(pn, pm, psel);
                    *(LAS unsigned*)(gbase + ((2 * k & 3) + par + 8 * (k >> 1)) * 128) = ow; }
            }
        }
        if (!FINAL && hh == 0) *(f32x2*)(agg + ((size_t)(b * 64 + tc) * 512 + chn) * 2) = (f32x2){atot, carry};
    }
    LDS_WAIT(); asm volatile("" ::: "memory");
    if (FINAL) {
#pragma unroll
        for (int i = 0; i < 8; ++i) *(u32x4*)(WSP(bf16_t, WS_YMIX) + (row0 + i * 8 + lr) * DM + w * 64 + lc * 8) = *(const LAS u32x4*)(xa + (i * 8 + lr) * 128 + lc * 16);
    }
    LDS_WAIT(); asm volatile("" ::: "memory");
}
template <bool FINAL> __device__ __forceinline__ void phase_lru(Frame& F, int e) {
    const int skip = (!FINAL && F.G >= 128) ? 32 : 0;
    if (F.bx < skip) return;
    for (int u = F.bx - skip; u < NB * 64; u += F.G - skip) lru_unit<FINAL>(F, e, u >> 6, u & 63);
}

constexpr int NSA_KROW = 144, NSA_VROW = 144;
constexpr int NSA_KB0 = 0, NSA_VB0 = 9216, NSA_KB1 = 18432, NSA_VB1 = 27648, NSA_SLAB = 36864, NSA_SELM = NSA_SLAB + 4 * 64 * 65 * 4;
constexpr float NSA_SC = 0.125f * 1.4426950408889634f, NSA_THR = 8.0f;
struct NsaTile { u32x4 k, v; };
__device__ __forceinline__ void nsa_load(NsaTile& r, __amdgpu_buffer_rsrc_t rs, unsigned kbase, unsigned kld, unsigned vbase, unsigned vld, int tid) {
    const unsigned rr = (unsigned)tid >> 3, cc = (unsigned)tid & 7u;
    r.k = __builtin_amdgcn_raw_buffer_load_b128(rs, (int)((rr * kld + cc * 8u) * 2u), (int)kbase, 0);
    r.v = __builtin_amdgcn_raw_buffer_load_b128(rs, (int)((rr * vld + cc * 8u) * 2u), (int)vbase, 0);
}
__device__ __forceinline__ void nsa_store(const NsaTile& r, LAS unsigned char* lds, int buf, int tid) {
    const int rr = tid >> 3, cc = tid & 7; LAS unsigned char* kb = lds + (buf ? NSA_KB1 : NSA_KB0), *vb = lds + (buf ? NSA_VB1 : NSA_VB0);
    *(LAS u32x4*)(kb + rr * NSA_KROW + cc * 16) = r.k;
    LAS unsigned char* vrow = vb + rr * NSA_VROW + (cc >> 1) * 32 + (cc & 1) * 8;
    *(LAS u32x2*)(vrow) = (u32x2){r.v.x, r.v.y}; *(LAS u32x2*)(vrow + 16) = (u32x2){r.v.z, r.v.w};
}
__device__ __forceinline__ void nsa_scores(const LAS unsigned char* kb, const bf16x8 (&qf)[4], int l31, int hh, f32x16& s0, f32x16& s1) {
    s0 = zero16(); s1 = zero16();
    bf16x8 a0[4], a1[4];
#pragma unroll
    for (int s = 0; s < 4; ++s) { a0[s] = *(const LAS bf16x8*)(kb + l31 * NSA_KROW + (16 * s + 8 * hh) * 2); a1[s] = *(const LAS bf16x8*)(kb + (l31 + 32) * NSA_KROW + (16 * s + 8 * hh) * 2); }
    __builtin_amdgcn_sched_barrier(0);
#pragma unroll
    for (int s = 0; s < 4; ++s) { s0 = mfma32(a0[s], qf[s], s0); s1 = mfma32(a1[s], qf[s], s1); }
}
#define KJ(kb, r) (32 * (kb) + ((r) & 3) + 8 * ((r) >> 2))
__device__ __forceinline__ void nsa_pv(const LAS unsigned char* vb, const bf16x8 (&pf)[2][2], int l31, int hh, f32x16 (&o)[2]) {
    bf16x8 vf[2][2][2];
#pragma unroll
    for (int dh = 0; dh < 2; ++dh)
#pragma unroll
        for (int kb = 0; kb < 2; ++kb)
#pragma unroll
            for (int st = 0; st < 2; ++st) vf[dh][kb][st] = *(const LAS bf16x8*)(vb + (32 * dh + l31) * NSA_VROW + (32 * kb + 16 * st) * 2 + 16 * hh);
    __builtin_amdgcn_sched_barrier(0);
#pragma unroll
    for (int dh = 0; dh < 2; ++dh)
#pragma unroll
        for (int kb = 0; kb < 2; ++kb)
#pragma unroll
            for (int st = 0; st < 2; ++st) o[dh] = mfma32(vf[dh][kb][st], pf[kb][st], o[dh]);
}
__device__ __forceinline__ void nsa_step(const int MODE, const LAS unsigned char* kb, const LAS unsigned char* vb, const bf16x8 (&qf)[4], bool rowok, int qi, int l31, int hh, float& m, float& l, f32x16 (&o)[2]) {
    f32x16 s[2]; nsa_scores(kb, qf, l31, hh, s[0], s[1]);
    const int q2 = qi - 4 * hh;
    const float nmask = rowok ? 0.f : -3e38f;
    if (MODE != 0) {
        const bool diag = MODE == 1;
#pragma unroll
        for (int b2 = 0; b2 < 2; ++b2)
#pragma unroll
            for (int r = 0; r < 16; ++r) { const bool le = KJ(b2, r) <= q2; s[b2][r] = (le == diag) ? s[b2][r] : -1e30f; }
        asm volatile("" ::: "memory");
    }
#pragma unroll
    for (int b2 = 0; b2 < 2; ++b2) {
        bf16x8 vf[2][2];
#pragma unroll
        for (int dh = 0; dh < 2; ++dh)
#pragma unroll
            for (int st = 0; st < 2; ++st) vf[dh][st] = *(const LAS bf16x8*)(vb + (32 * dh + l31) * NSA_VROW + (32 * b2 + 16 * st) * 2 + 16 * hh);
        __builtin_amdgcn_sched_barrier(0);
        float mx = -1e30f;
#pragma unroll
        for (int r = 0; r < 16; ++r) mx = fmaxf(mx, s[b2][r]);
        mx = rowok ? mx * NSA_SC : -1e30f;
        mx = fmaxf(mx, xchg32(mx, hh));
        if (!__all(mx <= m + NSA_THR)) { const float mn = fmaxf(m, mx); const float alpha = fast_exp2(m - mn); l *= alpha; m = mn;
#pragma unroll
            for (int dh = 0; dh < 2; ++dh)
#pragma unroll
                for (int r = 0; r < 16; ++r) o[dh][r] *= alpha; }
        const float nm = nmask - m; f32x2 ls2 = {0.f, 0.f};
#pragma unroll
        for (int r = 0; r < 16; r += 2) { const f32x2 sv = {s[b2][r], s[b2][r + 1]}; const f32x2 t = sv * (f32x2){NSA_SC, NSA_SC} + (f32x2){nm, nm};
            const f32x2 p = {fast_exp2(t.x), fast_exp2(t.y)}; s[b2][r] = p.x; s[b2][r + 1] = p.y; ls2 += p; }
        l += ls2.x + ls2.y;
        bf16x8 pf[2];
#pragma unroll
        for (int st = 0; st < 2; ++st) pf[st] = pack8(s[b2][8 * st], s[b2][8 * st + 1], s[b2][8 * st + 2], s[b2][8 * st + 3], s[b2][8 * st + 4], s[b2][8 * st + 5], s[b2][8 * st + 6], s[b2][8 * st + 7]);
        __builtin_amdgcn_sched_barrier(0);
#pragma unroll
        for (int dh = 0; dh < 2; ++dh)
#pragma unroll
            for (int st = 0; st < 2; ++st) o[dh] = mfma32(vf[dh][st], pf[st], o[dh]);
    }
}

__device__ __forceinline__ void nsa_unit(Frame& F, int bg, int c) {
    const int tid = F.tid, w = F.wave, lane = F.lane, l31 = lane & 31, hh = lane >> 5;
    const int b = bg >> 1, g = bg & 1, hd4 = w >> 1, hd = 4 * g + hd4, qi = 32 * (w & 1) + l31;
    const bf16_t* proj = WSP(bf16_t, WS_RA); const bf16_t* vtg = (const bf16_t*)(F.ws + WS_RA + RA_PROJB);
    const size_t tok0 = (size_t)b * SEQ, tok = tok0 + 64 * c + qi;
    LAS unsigned char* lds = F.lds; LAS float* slab = (LAS float*)(lds + NSA_SLAB);
    const __amdgpu_buffer_rsrc_t rs = __builtin_amdgcn_make_buffer_rsrc((void*)(unsigned char*)F.ws, 0, 0xFFFFFFFFu, 0x00020000);
    bf16x8 qn[4], qr0;
#pragma unroll
    for (int s = 0; s < 4; ++s) qn[s] = *(const bf16x8*)(proj + tok * PA_N + 1024 + hd * 64 + 16 * s + 8 * hh);
    { const u32x4 mine = __builtin_bit_cast(u32x4, qn[0]); u32x4 oth; oth.x = __shfl_xor(mine.x, 32); oth.y = __shfl_xor(mine.y, 32); oth.z = __shfl_xor(mine.z, 32); oth.w = __shfl_xor(mine.w, 32);
      const f32x4* rp = (const f32x4*)(WSP(float, WS_ROPE) + tok * 16); const f32x4 c0 = rp[0], c1 = rp[1], s0 = rp[2], s1 = rp[3];
      const float sg = hh ? 1.f : -1.f;
      float xm[8] = {bflo(mine.x), bfhi(mine.x), bflo(mine.y), bfhi(mine.y), bflo(mine.z), bfhi(mine.z), bflo(mine.w), bfhi(mine.w)};
      float xo[8] = {bflo(oth.x), bfhi(oth.x), bflo(oth.y), bfhi(oth.y), bflo(oth.z), bfhi(oth.z), bflo(oth.w), bfhi(oth.w)};
      float cs[8] = {c0.x, c0.y, c0.z, c0.w, c1.x, c1.y, c1.z, c1.w}, sn[8] = {s0.x, s0.y, s0.z, s0.w, s1.x, s1.y, s1.z, s1.w};
      float y[8];
#pragma unroll
      for (int j = 0; j < 8; ++j) y[j] = xm[j] * cs[j] + sg * xo[j] * sn[j];
      qr0 = pack8(y[0], y[1], y[2], y[3], y[4], y[5], y[6], y[7]); }
    float gate[3];
#pragma unroll
    for (int j = 0; j < 3; ++j) gate[j] = sigmoidf_(bf2f(vtg[(size_t)(256 + hd * 3 + j) * NTOK + tok]));
    for (int i = tid; i < 4 * 64 * 65; i += 512) slab[i] = 0.f;
    f32x16 comb[2]; comb[0] = zero16(); comb[1] = zero16();
    NsaTile tl;
    {
        const unsigned kc = (unsigned)WS_KCMP + (unsigned)bg * 256 * 64 * 2, vct = (unsigned)(WS_KCMP + 512 * 1024) + (unsigned)bg * 64 * 256 * 2;
        const int ktmax = c >> 4, nmaxq = (64 * c + qi - 31) >> 4;
        float m = -1e30f, l = 0.f;
        nsa_load(tl, rs, kc, 64, vct, 256, tid); nsa_store(tl, lds, 0, tid); __syncthreads();
        for (int kt = 0; kt <= ktmax; ++kt) {
            if (kt < ktmax) nsa_load(tl, rs, kc + (unsigned)(kt + 1) * 64 * 64 * 2, 64, vct + (unsigned)(kt + 1) * 64 * 2, 256, tid);
            f32x16 s[2]; nsa_scores(lds + ((kt & 1) ? NSA_KB1 : NSA_KB0), qn, l31, hh, s[0], s[1]);
            const int hi = nmaxq - 64 * kt - 4 * hh; float mx = -1e30f;
#pragma unroll
            for (int b2 = 0; b2 < 2; ++b2)
#pragma unroll
                for (int r = 0; r < 16; ++r) { const float x = (KJ(b2, r) <= hi) ? s[b2][r] * NSA_SC : -1e30f; s[b2][r] = x; mx = fmaxf(mx, x); }
            mx = fmaxf(mx, __shfl_xor(mx, 32)); const float mn = fmaxf(m, mx); float ls = 0.f;
#pragma unroll
            for (int b2 = 0; b2 < 2; ++b2)
#pragma unroll
                for (int r = 0; r < 16; ++r) ls += (s[b2][r] > -1e29f) ? fast_exp2(s[b2][r] - mn) : 0.f;
            ls += __shfl_xor(ls, 32); l = l * fast_exp2(m - mn) + ls; m = mn;
            if (kt < ktmax) nsa_store(tl, lds, (kt + 1) & 1, tid);
            __syncthreads();
        }
        const float inv_l = l > 0.f ? 1.0f / l : 0.f;
        f32x16 o[2]; o[0] = zero16(); o[1] = zero16();
        nsa_load(tl, rs, kc, 64, vct, 256, tid); nsa_store(tl, lds, 0, tid); __syncthreads();
        float icarry = 0.f;
        for (int kt = 0; kt <= ktmax; ++kt) {
            if (kt < ktmax) nsa_load(tl, rs, kc + (unsigned)(kt + 1) * 64 * 64 * 2, 64, vct + (unsigned)(kt + 1) * 64 * 2, 256, tid);
            f32x16 s[2]; nsa_scores(lds + ((kt & 1) ? NSA_KB1 : NSA_KB0), qn, l31, hh, s[0], s[1]);
            const int hi = nmaxq - 64 * kt - 4 * hh;
#pragma unroll
            for (int b2 = 0; b2 < 2; ++b2)
#pragma unroll
                for (int r = 0; r < 16; ++r) s[b2][r] = (KJ(b2, r) <= hi) ? fast_exp2(s[b2][r] * NSA_SC - m) * inv_l : 0.f;
            { float own[8], pl[8];
#pragma unroll
              for (int b2 = 0; b2 < 2; ++b2)
#pragma unroll
                  for (int q4 = 0; q4 < 4; ++q4) { own[4 * b2 + q4] = (s[b2][4 * q4] + s[b2][4 * q4 + 1]) + (s[b2][4 * q4 + 2] + s[b2][4 * q4 + 3]); pl[4 * b2 + q4] = xchg32(s[b2][4 * q4 + 3], hh); }
              LAS float* sp = slab + (hd4 * 64 + qi) * 65 + 16 * kt + hh;
#pragma unroll
              for (int i = 0; i < 8; ++i) sp[2 * i] = own[i] + (hh ? pl[i] : (i ? pl[i - 1] : icarry));
              icarry = pl[7];
              if (kt == ktmax && hh == 0 && 16 * (kt + 1) < 64) sp[16] = icarry; }
            bf16x8 pf[2][2];
#pragma unroll
            for (int b2 = 0; b2 < 2; ++b2)
#pragma unroll
                for (int st = 0; st < 2; ++st) pf[b2][st] = pack8(s[b2][8 * st], s[b2][8 * st + 1], s[b2][8 * st + 2], s[b2][8 * st + 3], s[b2][8 * st + 4], s[b2][8 * st + 5], s[b2][8 * st + 6], s[b2][8 * st + 7]);
            nsa_pv(lds + ((kt & 1) ? NSA_VB1 : NSA_VB0), pf, l31, hh, o);
            if (kt < ktmax) nsa_store(tl, lds, (kt + 1) & 1, tid);
            __syncthreads();
        }
#pragma unroll
        for (int dh = 0; dh < 2; ++dh)
#pragma unroll
            for (int r = 0; r < 16; ++r) comb[dh][r] = gate[0] * o[dh][r];
    }
    {
        LAS unsigned long long* selm = (LAS unsigned long long*)(lds + NSA_SELM);
        if (c < 16) {
            if (lane < 8) selm[8 * w + lane] = (2ull << c) - 1ull;
        } else {
            const bool causal = lane <= c, forced = (lane == 0) || (lane == c) || (lane == c - 1);
#pragma unroll 1
            for (int g4 = 0; g4 < 2; ++g4) {
                unsigned key[4], T[4];
#pragma unroll
                for (int j = 0; j < 4; ++j) { const int q = 8 * w + 4 * g4 + j;
                    const float imp = ((slab[(0 * 64 + q) * 65 + lane] + slab[(1 * 64 + q) * 65 + lane]) + slab[(2 * 64 + q) * 65 + lane]) + slab[(3 * 64 + q) * 65 + lane];
                    key[j] = causal ? (forced ? 0xFFFFFFFFu : __float_as_uint(fmaxf(imp, 0.f))) : 0u; T[j] = 0u; }
#pragma unroll
                for (int bit = 31; bit >= 0; --bit) {
#pragma unroll
                    for (int j = 0; j < 4; ++j) { const unsigned cand = T[j] | (1u << bit); const unsigned long long bm = __builtin_amdgcn_ballot_w64(key[j] >= cand); const int cnt = __builtin_popcount((unsigned)bm) + __builtin_popcount((unsigned)(bm >> 32)); T[j] = cnt >= 16 ? cand : T[j]; } }
#pragma unroll
                for (int j = 0; j < 4; ++j) { const int q = 8 * w + 4 * g4 + j;
                    const unsigned long long gt = __ballot(key[j] > T[j]); const bool iseq = key[j] == T[j]; const unsigned long long eq = __ballot(iseq); const int need = 16 - __popcll(gt);
                    const int below = (int)__builtin_amdgcn_mbcnt_hi((unsigned)(eq >> 32), __builtin_amdgcn_mbcnt_lo((unsigned)eq, 0u));
                    const unsigned long long pick = __ballot(iseq && below < need);
                    if (lane == 0) selm[q] = gt | pick; } }
        }
        __syncthreads();
    }
    const unsigned long long mysel = ((const LAS unsigned long long*)(lds + NSA_SELM))[qi];
    qn[0] = qr0;
#pragma unroll 1
    for (int br = 0; br < 2; ++br) {
        const unsigned kbase = (unsigned)WS_RA + (unsigned)((unsigned)tok0 * PA_N + (br ? 1920 : 1792) + 64 * g) * 2u, vbase = (unsigned)(WS_RA + RA_PROJB) + (unsigned)(((br ? 128 : 0) + 64 * g) * NTOK + (unsigned)tok0) * 2u;
        const int ntile = br ? ((c < 8 ? c : 8) + 1) : (c + 1);
        float m = -1e30f, l = 0.f; f32x16 o[2]; o[0] = zero16(); o[1] = zero16();
        { const int kb0 = br ? c : 0; nsa_load(tl, rs, kbase + (unsigned)kb0 * 64 * PA_N * 2, PA_N, vbase + (unsigned)kb0 * 64 * 2, NTOK, tid); nsa_store(tl, lds, 0, tid);
          if (ntile > 1) { const int kn = br ? (c - 1) : 1; nsa_load(tl, rs, kbase + (unsigned)kn * 64 * PA_N * 2, PA_N, vbase + (unsigned)kn * 64 * 2, NTOK, tid); }
          __syncthreads(); }
        for (int it = 0; it < ntile; ++it) {
            const int kb = br ? (c - it) : it;
            if (it + 1 < ntile) nsa_store(tl, lds, (it + 1) & 1, tid);
            if (it + 2 < ntile) { const int kn = br ? (c - it - 2) : (it + 2); nsa_load(tl, rs, kbase + (unsigned)kn * 64 * PA_N * 2, PA_N, vbase + (unsigned)kn * 64 * 2, NTOK, tid); }
            const bool rowok = br ? true : (((mysel >> kb) & 1ull) != 0ull);
            const LAS unsigned char* kbuf = lds + ((it & 1) ? NSA_KB1 : NSA_KB0); const LAS unsigned char* vbuf = lds + ((it & 1) ? NSA_VB1 : NSA_VB0);
            nsa_step(kb == c ? 1 : (br && kb == c - 8) ? 2 : 0, kbuf, vbuf, qn, rowok, qi, l31, hh, m, l, o);
            __syncthreads();
        }
        l += xchg32(l, hh);
        const float gl = gate[1 + br] * (l > 0.f ? 1.0f / l : 0.f);
#pragma unroll
        for (int dh = 0; dh < 2; ++dh)
#pragma unroll
            for (int r = 0; r < 16; ++r) comb[dh][r] += gl * o[dh][r];
    }
    bf16_t* yo = WSP(bf16_t, WS_YMIX) + tok * DM + 512 + hd * 64;
#pragma unroll
    for (int dh = 0; dh < 2; ++dh)
#pragma unroll
        for (int q4 = 0; q4 < 4; ++q4) { u32x2 pk; pk.x = cvt_pk_bf16(comb[dh][4 * q4], comb[dh][4 * q4 + 1]); pk.y = cvt_pk_bf16(comb[dh][4 * q4 + 2], comb[dh][4 * q4 + 3]);
            *(u32x2*)(yo + 32 * dh + 8 * q4 + 4 * hh) = pk; }
    __syncthreads();
}
__device__ __forceinline__ void phase_nsa(Frame& F) {
    for (int u = F.bx; u < 1024; u += F.G) { const int round = u >> 8, bl = u & 255, bg = (bl & 7) * 2 + (bl >> 7), jj = (bl >> 3) & 15;
        const int c = round == 0 ? jj : round == 1 ? 31 - jj : round == 2 ? 32 + jj : 63 - jj; nsa_unit(F, bg, c); }
}

struct CmpOrder { unsigned projA, w1; int G, c;
    __device__ bool next(int i, Unit& u) const { const int L = i * G + c; if (L >= 32) return false; u.x0 = L >> 4; u.pm = L & 15; u.pn = 0; u.x1 = 0; u.rows = nullptr; u.bd = 0;
        const int b = u.pm >> 1, g = u.pm & 1; u.a = projA + (unsigned)(b * SEQ * PA_N + (u.x0 ? 1664 : 1536) + 64 * g) * 2; u.b = w1 + (unsigned)u.x0 * 256 * 1024 * 2; return true; }
};
struct EpiCompress {
    static constexpr bool PERM = false, AFTER_DRAIN = true;
    const bf16_t* w2t;
    const float* pb;
    bf16_t* kcmp; bf16_t* vct;
    __device__ __forceinline__ void operator()(const AccT&, const Unit&, int, int, int, int) const {}
    __device__ __forceinline__ void fused(AccT& acc, const Unit& u, int wr, int wc, int fr, int fq, LAS unsigned char* lds, int wid, int lane) const {
        LAS float* P2 = (LAS float*)lds;
        asm volatile("" ::: "memory"); __syncthreads();
        LAS unsigned char* Hb = lds;
#pragma unroll
        for (int ai = 0; ai < 2; ++ai)
#pragma unroll
            for (int m = 0; m < 4; ++m) { const int r = ai * 128 + wr * 64 + m * 16 + fr;
#pragma unroll
                for (int n = 0; n < 2; ++n) *(LAS f32x4*)(P2 + r * 128 + wc * 32 + n * 16 + 4 * fq) = acc[ai][1][m][n]; }
        __syncthreads();
        const float* pbk = pb + u.x0 * 128;
#pragma unroll
        for (int ai = 0; ai < 2; ++ai)
#pragma unroll
            for (int m = 0; m < 4; ++m) { const int r = ai * 128 + wr * 64 + m * 16 + fr;
#pragma unroll
                for (int n = 0; n < 2; ++n) { const int c0 = wc * 32 + n * 16 + 4 * fq; const f32x4 sh = (r < 255) ? *(const LAS f32x4*)(P2 + (r + 1) * 128 + c0) : (f32x4){0.f, 0.f, 0.f, 0.f}; const f32x4 bv = *(const f32x4*)(pbk + c0);
                    f32x4 v = acc[ai][0][m][n] + sh + bv;
#pragma unroll
                    for (int j = 0; j < 4; ++j) v[j] = gelu_tanh(v[j]);
                    acc[ai][0][m][n] = v; } }
        __syncthreads();
#pragma unroll
        for (int ai = 0; ai < 2; ++ai)
#pragma unroll
            for (int m = 0; m < 4; ++m) { const int r = ai * 128 + wr * 64 + m * 16 + fr;
#pragma unroll
                for (int n = 0; n < 2; ++n) { const f32x4 v = acc[ai][0][m][n]; u32x2 pk; pk.x = cvt_pk_bf16(v[0], v[1]); pk.y = cvt_pk_bf16(v[2], v[3]);
                    *(LAS u32x2*)(Hb + r * 272 + (wc * 32 + n * 16 + 4 * fq) * 2) = pk; } }
        __syncthreads();
        const int l31 = lane & 31, hh = lane >> 5; const bf16_t* w2 = w2t + (size_t)u.x0 * 64 * 128; const int bg = u.pm;
        bf16x8 hf[8];
#pragma unroll
        for (int s = 0; s < 8; ++s) hf[s] = *(const LAS bf16x8*)(Hb + (32 * wid + l31) * 272 + (16 * s + 8 * hh) * 2);
#pragma unroll
        for (int db = 0; db < 2; ++db) { f32x16 o = zero16();
            if (u.x0 == 0) {
#pragma unroll
                for (int s = 0; s < 8; ++s) { const bf16x8 wf = *(const bf16x8*)(w2 + (32 * db + l31) * 128 + 16 * s + 8 * hh); o = mfma32(wf, hf[s], o); }
                const int i = 32 * wid + l31;
#pragma unroll
                for (int q4 = 0; q4 < 4; ++q4) { u32x2 pk; pk.x = cvt_pk_bf16(o[4 * q4], o[4 * q4 + 1]); pk.y = cvt_pk_bf16(o[4 * q4 + 2], o[4 * q4 + 3]); if (i == 255) { pk.x = 0u; pk.y = 0u; }
                    *(u32x2*)(kcmp + ((size_t)bg * 256 + i) * 64 + 32 * db + 8 * q4 + 4 * hh) = pk; }
            } else {
#pragma unroll
                for (int s = 0; s < 8; ++s) { const bf16x8 wf = *(const bf16x8*)(w2 + (32 * db + l31) * 128 + 16 * s + 8 * hh); o = mfma32(hf[s], wf, o); }
                const int d = 32 * db + l31;
#pragma unroll
                for (int q4 = 0; q4 < 4; ++q4) { const int i0 = 32 * wid + 8 * q4 + 4 * hh; float v3 = o[4 * q4 + 3]; if (i0 + 3 == 255) v3 = 0.f;
                    u32x2 pk; pk.x = cvt_pk_bf16(o[4 * q4], o[4 * q4 + 1]); pk.y = cvt_pk_bf16(o[4 * q4 + 2], v3);
                    *(u32x2*)(vct + ((size_t)bg * 64 + d) * 256 + i0) = pk; }
            } }
        __syncthreads();
    }
};

__device__ __forceinline__ void phase_oddconv(Frame& F, int o) {
    const bf16_t* Bg = WSP(bf16_t, WS_RA); const bf16_t* CV = (const bf16_t*)(F.ws + WS_RA + 64 * MiB); bf16_t* Z = WSP(bf16_t, WS_YMIX);
    const float* cw = INF(24) + (size_t)o * 3 * DM;
    const int cg = F.tid & 127, sub = F.tid >> 7;
    float w0[8], w1[8], w2[8];
#pragma unroll
    for (int j = 0; j < 8; ++j) { w0[j] = cw[cg * 8 + j]; w1[j] = cw[DM + cg * 8 + j]; w2[j] = cw[2 * DM + cg * 8 + j]; }
    for (int u = F.bx; u < NTOK / 64; u += F.G) {
        const int t0 = (u * 64 + sub * 16); const int tin = t0 & (SEQ - 1);
        u32x4 p2 = {0u, 0u, 0u, 0u}, p1 = p2;
        if (tin >= 2) { p2 = *(const u32x4*)(CV + (size_t)(t0 - 2) * DM + cg * 8); p1 = *(const u32x4*)(CV + (size_t)(t0 - 1) * DM + cg * 8); }
#pragma unroll 4
        for (int t = 0; t < 16; ++t) { const size_t off = (size_t)(t0 + t) * DM + cg * 8; const u32x4 c0 = *(const u32x4*)(CV + off), bb = *(const u32x4*)(Bg + off);
            float o8[8]; const unsigned a2[4] = {p2.x, p2.y, p2.z, p2.w}, a1[4] = {p1.x, p1.y, p1.z, p1.w}, a0[4] = {c0.x, c0.y, c0.z, c0.w}, ab[4] = {bb.x, bb.y, bb.z, bb.w};
#pragma unroll
            for (int j = 0; j < 4; ++j) { o8[2 * j] = bflo(ab[j]) * (w0[2 * j] * bflo(a2[j]) + w1[2 * j] * bflo(a1[j]) + w2[2 * j] * bflo(a0[j]));
                o8[2 * j + 1] = bfhi(ab[j]) * (w0[2 * j + 1] * bfhi(a2[j]) + w1[2 * j + 1] * bfhi(a1[j]) + w2[2 * j + 1] * bfhi(a0[j])); }
            u32x4 pk; pk.x = cvt_pk_bf16(o8[0], o8[1]); pk.y = cvt_pk_bf16(o8[2], o8[3]); pk.z = cvt_pk_bf16(o8[4], o8[5]); pk.w = cvt_pk_bf16(o8[6], o8[7]);
            *(u32x4*)(Z + off) = pk; p2 = p1; p1 = c0; }
    }
}

constexpr int XA_KROW = 144, XA_VROW = 528, XA_KBUF = 36864, XA_VBUF = 16896, XA_KOFF = 0, XA_VOFF = 2 * XA_KBUF;
__device__ __forceinline__ void xattn_unit(Frame& F, int layer, int b, int head, int qb) {
    const int tid = F.tid, w = F.wave, lane = F.lane, l31 = lane & 31, hh = lane >> 5;
    LAS unsigned char* lds = F.lds;
    const bf16_t* Q = WSP(bf16_t, WS_RA);
    const bf16_t* Kx = WSP(bf16_t, WS_XK) + ((size_t)layer * 2048 + b * 256) * DM + head * 256;
    const bf16_t* Vt = WSP(bf16_t, WS_XVT) + ((size_t)layer * DM + head * 256) * 2048 + b * 256;
    const size_t tok = (size_t)b * SEQ + qb * 256 + w * 32 + l31;
    const bf16_t* qrow = Q + tok * DM + head * 256;
    const int kkey = tid >> 1, khalf = tid & 1, vd = tid >> 4, vcc = tid & 15;
    f32x16 s[8];
#pragma unroll
    for (int kb = 0; kb < 8; ++kb) s[kb] = zero16();
    u32x4 kr[4];
    { const u32x4* src = (const u32x4*)(Kx + (size_t)kkey * DM + khalf * 32); kr[0] = src[0]; kr[1] = src[1]; kr[2] = src[2]; kr[3] = src[3]; }
    { LAS u32x4* dst = (LAS u32x4*)(lds + XA_KOFF + kkey * XA_KROW + khalf * 64); dst[0] = kr[0]; dst[1] = kr[1]; dst[2] = kr[2]; dst[3] = kr[3]; }
    u32x4 vr[2];
#pragma unroll 1
    for (int ch = 0; ch < 4; ++ch) {
        bf16x8 qf[4];
#pragma unroll
        for (int s4 = 0; s4 < 4; ++s4) qf[s4] = *(const bf16x8*)(qrow + ch * 64 + 16 * s4 + 8 * hh);
        if (ch < 3) { const u32x4* src = (const u32x4*)(Kx + (size_t)kkey * DM + (ch + 1) * 64 + khalf * 32); kr[0] = src[0]; kr[1] = src[1]; kr[2] = src[2]; kr[3] = src[3]; }
        else { const u32x4* src = (const u32x4*)(Vt + (size_t)vd * 2048 + vcc * 16); vr[0] = src[0]; vr[1] = src[1]; }
        __syncthreads();
        const LAS unsigned char* kbuf = lds + XA_KOFF + (ch & 1) * XA_KBUF;
#pragma unroll
        for (int s4 = 0; s4 < 4; ++s4) {
#pragma unroll
            for (int k2 = 0; k2 < 2; ++k2) { bf16x8 kf[4];
#pragma unroll
                for (int kb = 0; kb < 4; ++kb) kf[kb] = *(const LAS bf16x8*)(kbuf + (32 * (4 * k2 + kb) + l31) * XA_KROW + (16 * s4 + 8 * hh) * 2);
                __builtin_amdgcn_sched_barrier(0);
#pragma unroll
                for (int kb = 0; kb < 4; ++kb) s[4 * k2 + kb] = mfma32(kf[kb], qf[s4], s[4 * k2 + kb]); } }
        if (ch < 3) { LAS u32x4* dst = (LAS u32x4*)(lds + XA_KOFF + ((ch + 1) & 1) * XA_KBUF + kkey * XA_KROW + khalf * 64); dst[0] = kr[0]; dst[1] = kr[1]; dst[2] = kr[2]; dst[3] = kr[3]; }
    }
#define XA_VSTORE(buf) do { LAS u32x2* dst = (LAS u32x2*)(lds + XA_VOFF + (buf) * XA_VBUF + vd * XA_VROW + vcc * 32); \
        dst[0] = (u32x2){vr[0].x, vr[0].y}; dst[2] = (u32x2){vr[0].z, vr[0].w}; dst[1] = (u32x2){vr[1].x, vr[1].y}; dst[3] = (u32x2){vr[1].z, vr[1].w}; } while (0)
    XA_VSTORE(0);
    constexpr float SC = 0.0625f * 1.4426950408889634f;
    float mx = -1e30f;
#pragma unroll
    for (int kb = 0; kb < 8; ++kb)
#pragma unroll
        for (int r = 0; r < 16; ++r) mx = fmaxf(mx, s[kb][r]);
    mx = fmaxf(mx, __shfl_xor(mx, 32)); const float mb = mx * SC; float ls = 0.f;
    bf16x8 pf[8][2];
#pragma unroll
    for (int kb = 0; kb < 8; ++kb) { float p[16];
#pragma unroll
        for (int r = 0; r < 16; ++r) { p[r] = fast_exp2(__builtin_fmaf(s[kb][r], SC, -mb)); ls += p[r]; }
        pf[kb][0] = pack8(p[0], p[1], p[2], p[3], p[4], p[5], p[6], p[7]); pf[kb][1] = pack8(p[8], p[9], p[10], p[11], p[12], p[13], p[14], p[15]); }
    ls += __shfl_xor(ls, 32); const float inv = __builtin_amdgcn_rcpf(ls);
#pragma unroll 1
    for (int db = 0; db < 8; ++db) {
        if (db < 7) { const u32x4* src = (const u32x4*)(Vt + (size_t)(32 * (db + 1) + vd) * 2048 + vcc * 16); vr[0] = src[0]; vr[1] = src[1]; }
        __syncthreads();
        const LAS unsigned char* vbuf = lds + XA_VOFF + (db & 1) * XA_VBUF;
        f32x16 o = zero16();
#pragma unroll
        for (int k4 = 0; k4 < 4; ++k4) { bf16x8 vf[4];
#pragma unroll
            for (int i = 0; i < 4; ++i) vf[i] = *(const LAS bf16x8*)(vbuf + l31 * XA_VROW + (32 * (2 * k4 + (i >> 1)) + 16 * (i & 1)) * 2 + 16 * hh);
            __builtin_amdgcn_sched_barrier(0);
#pragma unroll
            for (int i = 0; i < 4; ++i) o = mfma32(vf[i], pf[2 * k4 + (i >> 1)][i & 1], o); }
        bf16_t* orow = WSP(bf16_t, WS_YMIX) + tok * DM + head * 256 + 32 * db;
#pragma unroll
        for (int q4 = 0; q4 < 4; ++q4) { u32x2 pk; pk.x = cvt_pk_bf16(o[4 * q4] * inv, o[4 * q4 + 1] * inv); pk.y = cvt_pk_bf16(o[4 * q4 + 2] * inv, o[4 * q4 + 3] * inv);
            *(u32x2*)(orow + 8 * q4 + 4 * hh) = pk; }
        if (db < 7) XA_VSTORE((db + 1) & 1);
    }
    __syncthreads();
#undef XA_VSTORE
}
__device__ __forceinline__ void phase_xattn(Frame& F, int layer) {
    for (int u = F.bx; u < NB * 4 * 16; u += F.G) xattn_unit(F, layer, u >> 6, (u >> 4) & 3, u & 15);
}

__device__ __forceinline__ void phase_router(Frame& F, int layer) {
    const int tid = F.tid, w = F.wave, lane = F.lane, l31 = lane & 31, hh = lane >> 5;
    LAS int* lcnt = (LAS int*)(F.lds + 8 * 16640);
    float* route_w = (float*)(F.ws + WS_ROUTE + 512 * 1024); int* perm = WSP(int, WS_PERM);
    unsigned* gcnt = WSP(unsigned, WS_CTL) + CW_CNT + layer * 32 * 16;
    for (int base = F.bx * 128; base < NTOK; base += F.G * 128) {
        if (tid < 64) lcnt[tid] = 0;
        __syncthreads();
        int e0 = 0, rk0 = 0; const int tok = base + w * 32 + l31;
        if (w < 4) {
            const bf16_t* wr = WSP(bf16_t, WS_W_RT) + (size_t)layer * 32 * DM + (size_t)l31 * DM; const bf16_t* xr = WSP(bf16_t, WS_HB) + (size_t)tok * DM;
            f32x16 acc = zero16();
#pragma unroll 8
            for (int s = 0; s < 64; ++s) { const bf16x8 a = *(const bf16x8*)(wr + 16 * s + 8 * hh), bq = *(const bf16x8*)(xr + 16 * s + 8 * hh); acc = mfma32(a, bq, acc); }
            float mine[12], oth[12];
#pragma unroll
            for (int r = 0; r < 12; ++r) { mine[r] = acc[r]; oth[r] = __shfl_xor(acc[r], 32); }
            const float rs = row_rstd(WSP(float, WS_SSQ), tok);
            if (hh == 0) ((float*)(F.ws + WS_ROUTE + 768 * 1024))[tok] = rs;
            float lg[20];
#pragma unroll
            for (int n = 0; n < 20; ++n) { const int hn = (n >> 2) & 1, r = (n & 3) + 4 * (n >> 3); lg[n] = (hh == hn) ? mine[r] : oth[r]; }
            const float* bgp = INF(31) + layer * 4; const float* bep = INF(33) + layer * 16;
            float gl[4]; int gi = 0; float gm = -1e30f;
#pragma unroll
            for (int j = 0; j < 4; ++j) { gl[j] = lg[j] * rs + bgp[j]; if (gl[j] > gm) { gm = gl[j]; gi = j; } }
            float gs = 0.f;
#pragma unroll
            for (int j = 0; j < 4; ++j) gs += __expf(gl[j] - gm);
            const float gtop = 1.0f / gs;
            float el[4];
#pragma unroll
            for (int j = 0; j < 4; ++j) { float v = 0.f;
#pragma unroll
                for (int g2 = 0; g2 < 4; ++g2) v = (gi == g2) ? (lg[4 + 4 * g2 + j] * rs + bep[4 * g2 + j]) : v;
                el[j] = v; }
            int i0 = 0; float v0 = el[0];
#pragma unroll
            for (int j = 1; j < 4; ++j) if (el[j] > v0) { v0 = el[j]; i0 = j; }
            int i1 = -1; float v1 = -1e30f;
#pragma unroll
            for (int j = 0; j < 4; ++j) if (j != i0 && el[j] > v1) { v1 = el[j]; i1 = j; }
            const float ex = __expf(v1 - v0), w0 = gtop / (1.0f + ex), w1 = gtop * ex / (1.0f + ex);
            { const int a = i0 < i1 ? i0 : i1, b2 = i0 < i1 ? i1 : i0; const int p6 = a == 0 ? b2 - 1 : a == 1 ? b2 + 1 : 5; e0 = gi * 6 + p6;
              if (hh == 0) { route_w[(size_t)tok * 2] = i0 < i1 ? w0 : w1; route_w[(size_t)tok * 2 + 1] = i0 < i1 ? w1 : w0; rk0 = atomicAdd((int*)&lcnt[e0], 1); } }
        }
        __syncthreads();
        if (tid < 32) { const int n = lcnt[tid]; lcnt[32 + tid] = n ? (int)atomicAdd(&gcnt[tid * 16], (unsigned)n) : 0; }
        __syncthreads();
        if (w < 4 && hh == 0) perm[(size_t)e0 * NTOK + lcnt[32 + e0] + rk0] = tok;
        __syncthreads();
    }
    moe_convert_drain(F, layer);
}

constexpr int MOE_NB = 24;
constexpr int MOE_TAB = LDS_MISC + 64;
__device__ __forceinline__ void moe_table(Frame& F, int layer) {
    LAS int* tab = (LAS int*)(F.lds + MOE_TAB);
    if (F.tid == 0) { const unsigned* gcnt = WSP(unsigned, WS_CTL) + CW_CNT + layer * 32 * 16; int acc = 0;
        for (int k = 0; k < MOE_NB; ++k) { const int n = (int)__hip_atomic_load(gcnt + k * 16, __ATOMIC_RELAXED, __HIP_MEMORY_SCOPE_AGENT); tab[k] = acc; tab[33 + k] = n; acc += (n + 255) >> 8; } tab[MOE_NB] = acc; }
    __syncthreads();
}
struct MoeOrder {
    const LAS int* tab; const int* perm; unsigned A, Bw; int G, c; bool down;
    __device__ bool next(int i, Unit& u) const {
        const int L = i * G + c, nt = tab[MOE_NB], q = L >> 3; int tile, sub;
        if (down) { sub = q & 3; tile = (q >> 2) * 8 + (L & 7); } else { sub = q & 7; tile = (q >> 3) * 8 + (L & 7); }
        if (tile >= nt) return false;
        int k = 0;
#pragma unroll 1
        for (int qq = 1; qq < MOE_NB; ++qq) if (tab[qq] <= tile) k = qq;
        const int rt = tile - tab[k], n = tab[33 + k], gi = k / 6, p6 = k - gi * 6;
        const int ea = gi * 4 + (p6 < 3 ? 0 : p6 < 5 ? 1 : 2), eb = gi * 4 + (p6 < 3 ? p6 + 1 : p6 < 5 ? p6 - 1 : 3);
        u.x0 = n - rt * 256 < 256 ? n - rt * 256 : 256; u.x1 = tile * 256; u.rows = perm + (size_t)k * NTOK + rt * 256; u.bd = 0;
        if (down) { u.pn = sub; u.pm = 0; u.a = A + (unsigned)tile * 256 * 1024 * 2; u.b = Bw + (unsigned)(ea * DM + sub * 256) * 512 * 2; u.bd = (eb - ea) * DM * 512 * 2 - 8 * 128; }
        else { const int sl = sub >> 2; u.pn = sub & 3; u.pm = sl; u.a = A; u.b = Bw + (unsigned)((sl ? eb : ea) * DM + u.pn * 256) * DM * 2; }
        return true; }
};

__device__ __forceinline__ void phase_final(Frame& F) {
    const int gw = F.bx * 8 + F.wave, NGW = F.G * 8; const f32x4* gp = (const f32x4*)INF(7) + F.lane;
    f32x4 gv[4];
#pragma unroll
    for (int j = 0; j < 4; ++j) gv[j] = gp[64 * j];
    for (int m = gw; m < NTOK; m += NGW) { const u32x2* hr = (const u32x2*)(WSP(bf16_t, WS_HB) + (size_t)m * DM) + F.lane; f32x4* xr = (f32x4*)(F.out + (size_t)m * DM) + F.lane; f32x4 v[4]; float s = 0.f;
#pragma unroll
        for (int j = 0; j < 4; ++j) { const u32x2 w = hr[64 * j]; v[j] = (f32x4){bflo(w.x), bfhi(w.x), bflo(w.y), bfhi(w.y)}; s += (v[j].x * v[j].x + v[j].y * v[j].y) + (v[j].z * v[j].z + v[j].w * v[j].w); }
        const float rs = 1.0f / sqrtf(wave_sum(s) * (1.0f / DM) + EPS);
#pragma unroll
        for (int j = 0; j < 4; ++j) xr[64 * j] = v[j] * rs * gv[j]; }
}

constexpr int NPHASE = 2 + 11 * DEPTH + 1;
template <unsigned PHMASK> __global__ void __launch_bounds__(512, 2) hybrid_fwd(Args args) {
    extern __shared__ __attribute__((aligned(16))) unsigned char lds_raw[];
    Frame F; F.lds = (LAS unsigned char*)lds_raw; F.tid = threadIdx.x; F.lane = F.tid & 63; F.wave = __builtin_amdgcn_readfirstlane(F.tid >> 6); F.G = gridDim.x; F.bx = blockIdx.x;
    F.ws = (GAS unsigned char*)args.ws; F.out = (GAS float*)args.out; F.in = args.in; F.z = 0;
    const int lo = (PHMASK == 0xFFFFu) ? 0 : args.ph_lo, hi = (PHMASK == 0xFFFFu) ? NPHASE : args.ph_hi;
    for (int u = F.tid; u < (LDS_BYTES - LDS_MISC) / 4; u += 512) ((LAS unsigned*)(F.lds + LDS_MISC))[u] = 0u;
    __syncthreads();
    if (hi - lo > 1) (void)xcd_barrier_post((unsigned*)(F.ws + WS_CTL) + CW_BAR, (volatile LAS unsigned*)(F.lds + LDS_MISC), F.tid);
#define PM(b) ((PHMASK >> (b)) & 1)
#define IN(p) (lo <= (p) && (p) < hi)
#define GRIDBAR() do { XcdBarrier b2_; b2_.bar = (unsigned*)(F.ws + WS_CTL) + CW_BAR; b2_.x = xb_xcc_id(); b2_.st = (volatile LAS unsigned*)(F.lds + LDS_MISC); asm volatile("" : "+s"(b2_.bar)); xcd_barrier(b2_, F.tid); } while (0)
#define SEAM(p) do { if ((p) + 1 < hi) GRIDBAR(); } while (0)
#define LAUNDER() do { asm volatile("" : "+v"(F.tid)); F.lane = F.tid & 63; asm volatile("" : "+s"(F.z)); asm volatile("" : "+s"(F.ws)); asm volatile("" : "+s"(F.bx)); asm volatile("" : "+s"(F.G)); } while (0)
    const pg8::Gemm gstd{DM, DM, 128, 128, DM, 0, 1 << 30};
#define ssq WSP(float, WS_SSQ)
#define hb WSP(bf16_t, WS_HB)

    if (PM(0) && IN(0)) { LAUNDER(); phase_prologue(F); SEAM(0); }
    if (PM(1) && IN(1)) { LAUNDER();
        KvOrder S{(unsigned)WS_MNHAT, (unsigned)WS_W_XK, (unsigned)WS_W_XV, F.G, F.bx};
        EpiPlainBf16 E{WSP(bf16_t, WS_XK), WSP(bf16_t, WS_XVT)};
        pg8::gemm_phase<EpiPlainBf16, KvOrder, false>(F.lds, (const unsigned char*)F.ws, gstd, S, E, F.tid);
        SEAM(1);
    }
#pragma unroll 1
    for (int layer = 0; layer < DEPTH; ++layer) {
        const int pb = 2 + 11 * layer, eo = layer >> 1;
        if ((layer & 1) == 0) {
            if (PM(2) && IN(pb + 0)) { LAUNDER();
                { pg8::DenseOrder S; S.init(WS_HB, WS_W_EINA + (size_t)eo * PA_N * DM * 2, NTOK, PA_N, DM, DM, F.G, F.bx);
                  EpiRowScale E{WSP(bf16_t, WS_RA), PA_N, ssq, WSP(float, WS_ROPE), 7};
                  pg8::gemm_phase<EpiRowScale, pg8::DenseOrder, false>(F.lds, (const unsigned char*)F.ws, gstd, S, E, F.tid); }
                { pg8::DenseOrder S; S.init(WS_W_EINB + (size_t)eo * PB_N * DM * 2, WS_HB, PB_N, NTOK, DM, DM, F.G, F.bx);
                  EpiColScale E{(bf16_t*)(F.ws + WS_RA + RA_PROJB), ssq};
                  pg8::gemm_phase<EpiColScale, pg8::DenseOrder, false>(F.lds, (const unsigned char*)F.ws, gstd, S, E, F.tid); }
                SEAM(pb + 0);
            }
            if (PM(3) && IN(pb + 1)) { LAUNDER();
                LAUNDER(); phase_lru<false>(F, eo);
                __syncthreads();
                { CmpOrder S{(unsigned)WS_RA, (unsigned)(WS_W_CMP1 + (size_t)eo * 2 * 256 * 1024 * 2), F.G, F.bx};
                  EpiCompress E{WSP(bf16_t, WS_W_CMP2) + (size_t)eo * 2 * 64 * 128, (const float*)(F.ws + WS_W_CMP2 + 512 * 1024) + eo * 256, WSP(bf16_t, WS_KCMP), (bf16_t*)(F.ws + WS_KCMP + 512 * 1024)};
                  const pg8::Gemm gc{16 * PA_N, 1024, PA_N * 2, 128, 1024, 0, 1 << 30};
                  pg8::gemm_phase<EpiCompress, CmpOrder, false>(F.lds, (const unsigned char*)F.ws, gc, S, E, F.tid); }
                SEAM(pb + 1);
            }
            if (PM(4) && IN(pb + 2)) { LAUNDER();
                phase_lru<true>(F, eo);
                __syncthreads(); LAUNDER();
                phase_nsa(F);
                SEAM(pb + 2); }
        } else {
            if (PM(5) && IN(pb + 0)) { LAUNDER();
                pg8::DenseOrder S; S.init(WS_HB, WS_W_OIN + (size_t)eo * 3072 * DM * 2, NTOK, 3072, DM, DM, F.G, F.bx);
                EpiOddIn E{WSP(bf16_t, WS_RA), (bf16_t*)(F.ws + WS_RA + 64 * MiB), ssq};
                pg8::gemm_phase<EpiOddIn, pg8::DenseOrder, false>(F.lds, (const unsigned char*)F.ws, gstd, S, E, F.tid);
                SEAM(pb + 0);
            }
            if (PM(6) && IN(pb + 1)) { LAUNDER(); phase_oddconv(F, eo); if (pb + 3 < hi) GRIDBAR(); }
        }
        if (PM(7) && IN(pb + 3)) { LAUNDER();
            pg8::DenseOrder S; S.init(WS_YMIX, ((layer & 1) ? WS_W_OOUT : WS_W_EOUT) + (size_t)eo * DM * DM * 2, NTOK, DM, DM, DM, F.G, F.bx);
            EpiResid E{hb, ssq};
            pg8::gemm_phase<EpiResid, pg8::DenseOrder, false>(F.lds, (const unsigned char*)F.ws, gstd, S, E, F.tid);
            SEAM(pb + 3);
        }
        if (PM(8) && IN(pb + 4)) { LAUNDER();
            pg8::DenseOrder S; S.init(WS_HB, WS_W_XQ + (size_t)layer * DM * DM * 2, NTOK, DM, DM, DM, F.G, F.bx);
            EpiRowScale E{WSP(bf16_t, WS_RA), DM, ssq, nullptr, -1};
            pg8::gemm_phase<EpiRowScale, pg8::DenseOrder, false>(F.lds, (const unsigned char*)F.ws, gstd, S, E, F.tid);
            SEAM(pb + 4);
        }
        if (PM(9) && IN(pb + 5)) { LAUNDER(); phase_xattn(F, layer); SEAM(pb + 5); }
        if (PM(10) && IN(pb + 6)) { LAUNDER();
            pg8::DenseOrder S; S.init(WS_YMIX, WS_W_XO + (size_t)layer * DM * DM * 2, NTOK, DM, DM, DM, F.G, F.bx);
            EpiResid E{hb, ssq};
            pg8::gemm_phase<EpiResid, pg8::DenseOrder, false>(F.lds, (const unsigned char*)F.ws, gstd, S, E, F.tid);
            SEAM(pb + 6);
        }
        if (PM(11) && IN(pb + 7)) { LAUNDER(); phase_router(F, layer); SEAM(pb + 7); }
        if (PM(12) && IN(pb + 8)) { LAUNDER();
            moe_table(F, layer);
            MoeOrder S{(const LAS int*)(F.lds + MOE_TAB), WSP(int, WS_PERM), (unsigned)WS_HB, (unsigned)((layer & 1) ? WS_MOE_GU2 : WS_MOE_GU), F.G, F.bx, false};
            EpiGateUp E{WSP(bf16_t, WS_RA), (const float*)(F.ws + WS_ROUTE + 768 * 1024), (const float*)(F.ws + WS_ROUTE + 512 * 1024)};
            const pg8::Gemm gg{DM, DM, 128, 128, DM, NTOK - 1, 1 << 30};
            pg8::gemm_phase<EpiGateUp, MoeOrder, true>(F.lds, (const unsigned char*)F.ws, gg, S, E, F.tid);
            __syncthreads(); moe_convert_drain(F, layer + 1);
            SEAM(pb + 8);
        }
        if (PM(13) && IN(pb + 9)) { LAUNDER();
            moe_table(F, layer);
            MoeOrder S{(const LAS int*)(F.lds + MOE_TAB), WSP(int, WS_PERM), (unsigned)WS_RA, (unsigned)((layer & 1) ? WS_MOE_D2 : WS_MOE_D), F.G, F.bx, true};
            EpiDown<true> E{hb, ssq, (const float*)(F.ws + WS_ROUTE + 512 * 1024), 0};
            const pg8::Gemm gd{1024, 512, 128, 128, 1024, 0, 8};
            pg8::gemm_phase<EpiDown<true>, MoeOrder, false>(F.lds, (const unsigned char*)F.ws, gd, S, E, F.tid);
            __syncthreads(); moe_convert_drain(F, layer + 1);
            SEAM(pb + 9);
        }
    }
    if (PM(15) && IN(NPHASE - 1)) { LAUNDER(); phase_final(F); }
}

static int phase_kind(int p) {
    if (p == 0) return 0; if (p == 1) return 1; if (p == NPHASE - 1) return 15;
    const int layer = (p - 2) / 11, k = (p - 2) % 11;
    if (k == 10) return -1;
    if (k >= 3) return 4 + k;
    if ((layer & 1) == 0) return 2 + k;
    return k == 0 ? 5 : k == 1 ? 6 : -1;
}
typedef void (*KernelFn)(Args);
template <unsigned M> static KernelFn kfn() { return hybrid_fwd<M>; }
#if MK_PER_PHASE
static KernelFn kind_fn(int kind) {
    switch (kind) {
        case 0: return kfn<1u << 0>(); case 1: return kfn<1u << 1>(); case 2: return kfn<1u << 2>(); case 3: return kfn<1u << 3>();
        case 4: return kfn<1u << 4>(); case 5: return kfn<1u << 5>(); case 6: return kfn<1u << 6>(); case 7: return kfn<1u << 7>();
        case 8: return kfn<1u << 8>(); case 9: return kfn<1u << 9>(); case 10: return kfn<1u << 10>(); case 11: return kfn<1u << 11>();
        case 12: return kfn<1u << 12>(); case 13: return kfn<1u << 13>(); case 14: return kfn<1u << 14>(); default: return kfn<1u << 15>();
    }
}
#endif
extern "C" void kernel_launch(void* const* d_in, const int* in_sizes, int n_in, void* d_out, int out_size, void* d_ws, size_t ws_size, hipStream_t stream) {
    static int grid = 0;
    if (grid == 0) {
        if (n_in != 37 || out_size != NTOK * DM || ws_size < WS_END) { fprintf(stderr, "kernel_launch: unexpected problem (n_in %d, out %d, ws %zu)\n", n_in, out_size, ws_size); grid = -1; return; }
        int dev = 0, cus = 0;
        if (hipGetDevice(&dev) != hipSuccess || hipDeviceGetAttribute(&cus, hipDeviceAttributeMultiprocessorCount, dev) != hipSuccess) { grid = -1; return; }
#if MK_PER_PHASE
        for (int k = 0; k < 16; ++k) if (hipFuncSetAttribute((const void*)kind_fn(k), hipFuncAttributeMaxDynamicSharedMemorySize, LDS_BYTES) != hipSuccess) { fprintf(stderr, "kernel_launch: hipFuncSetAttribute failed\n"); grid = -1; return; }
#else
        if (hipFuncSetAttribute((const void*)kfn<0xFFFFu>(), hipFuncAttributeMaxDynamicSharedMemorySize, LDS_BYTES) != hipSuccess) { fprintf(stderr, "kernel_launch: hipFuncSetAttribute failed\n"); grid = -1; return; }
        int per_cu = 0;
        if (hipOccupancyMaxActiveBlocksPerMultiprocessor(&per_cu, (const void*)kfn<0xFFFFu>(), 512, LDS_BYTES) != hipSuccess || per_cu < 1) { fprintf(stderr, "kernel_launch: occupancy query says %d\n", per_cu); }
#endif
        (void)hipGetLastError();
        grid = cus;
    }
    if (grid < 0) return;
    (void)hipMemsetAsync((char*)d_ws + WS_CTL, 0, CTL_BYTES, stream);
    Args a{};
    for (int i = 0; i < 37; ++i) a.in[i] = d_in[i];
    a.out = (float*)d_out; a.ws = (unsigned char*)d_ws;
#if MK_PER_PHASE
    for (int p = 0; p < NPHASE; ++p) { const int kind = phase_kind(p); if (kind < 0) continue;
        a.ph_lo = p; a.ph_hi = p + 1; hipLaunchKernelGGL(kind_fn(kind), dim3(grid), dim3(512), LDS_BYTES, stream, a); }
#else
    a.ph_lo = 0; a.ph_hi = NPHASE; hipLaunchKernelGGL(kfn<0xFFFFu>(), dim3(grid), dim3(512), LDS_BYTES, stream, a);
#endif
}
```

```cpp
#include <hip/hip_runtime.h>
#include <stdio.h>

#ifndef MK_PER_PHASE
#define MK_PER_PHASE 0
#endif

#define LAS __attribute__((address_space(3)))
typedef unsigned short bf16_t;
typedef short bf16x8 __attribute__((ext_vector_type(8)));
typedef short bf16x4 __attribute__((ext_vector_type(4)));
typedef float f32x2 __attribute__((ext_vector_type(2)));
typedef float f32x4 __attribute__((ext_vector_type(4)));
typedef float f32x16 __attribute__((ext_vector_type(16)));
typedef unsigned u32x2 __attribute__((ext_vector_type(2)));
typedef unsigned u32x4 __attribute__((ext_vector_type(4)));

constexpr int DM = 1024, NB = 8, SEQ = 4096, NTOK = NB * SEQ, DEPTH = 4, MEMLEN = 256;
constexpr int EPROJ = 2328;
constexpr int PA_N = 2048;
constexpr int PB_N = 512;
constexpr float EPS = 1e-6f;

constexpr size_t MiB = 1u << 20;
constexpr size_t WS_CTL = 0, CTL_BYTES = 1 * MiB;
constexpr size_t WS_W_EINA = 1 * MiB;
constexpr size_t WS_W_EINB = 9 * MiB;
constexpr size_t WS_W_EOUT = 11 * MiB;
constexpr size_t WS_W_OIN = 15 * MiB;
constexpr size_t WS_W_OOUT = 27 * MiB;
constexpr size_t WS_W_XQ = 31 * MiB, WS_W_XK = 39 * MiB, WS_W_XV = 47 * MiB, WS_W_XO = 55 * MiB;
constexpr size_t WS_W_RT = 63 * MiB;
constexpr size_t WS_W_LRU = 64 * MiB;
constexpr size_t WS_W_CMP1 = 65 * MiB;
constexpr size_t WS_W_CMP2 = 67 * MiB;
constexpr size_t WS_MOE_GU = 68 * MiB;
constexpr size_t WS_MOE_D = 100 * MiB;
constexpr size_t WS_XK = 116 * MiB;
constexpr size_t WS_XVT = 132 * MiB;
constexpr size_t WS_MNHAT = 148 * MiB;
constexpr size_t WS_ROPE = 152 * MiB;
constexpr size_t WS_SSQ = 154 * MiB;
constexpr size_t WS_LRUAGG = 156 * MiB;
constexpr size_t WS_KCMP = 158 * MiB;
constexpr size_t WS_ROUTE = 159 * MiB;
constexpr size_t WS_PERM = 160 * MiB;
constexpr size_t WS_HB = 164 * MiB;
constexpr size_t WS_YMIX = 228 * MiB;
constexpr size_t WS_RA = 292 * MiB;
constexpr size_t WS_MOE_GU2 = 452 * MiB;
constexpr size_t WS_MOE_D2 = 484 * MiB;
constexpr size_t WS_END = 500 * MiB;
constexpr size_t RA_PROJB = 128 * MiB;
constexpr int HMID_ROWS = 2 * NTOK + 32 * 256;

constexpr int CW_BAR = 4096;
constexpr int CW_Q = 20480;
constexpr int CW_CNT = 16384;

constexpr int LDS_STAGE = 131072;
constexpr int LDS_MISC = 143360;
constexpr int LDS_BYTES = 145408;

typedef __bf16 bf16x2n __attribute__((ext_vector_type(2)));
__device__ __forceinline__ unsigned cvt_pk_bf16(float lo, float hi) { const f32x2 v = {lo, hi}; return __builtin_bit_cast(unsigned, __builtin_convertvector(v, bf16x2n)); }
__device__ __forceinline__ float bflo(unsigned u) { return __uint_as_float(u << 16); }
__device__ __forceinline__ float bfhi(unsigned u) { return __uint_as_float(u & 0xffff0000u); }
__device__ __forceinline__ float bf2f(bf16_t b) { return __uint_as_float(((unsigned)b) << 16); }
__device__ __forceinline__ bf16_t f2bf(float f) { return (bf16_t)(cvt_pk_bf16(f, 0.f) & 0xffffu); }
__device__ __forceinline__ float fast_exp2(float x) { return __builtin_amdgcn_exp2f(x); }
__device__ __forceinline__ float sigmoidf_(float x) { return __builtin_amdgcn_rcpf(1.0f + __expf(-x)); }
__device__ __forceinline__ float gelu_tanh(float x) { const float z = 0.7978845608028654f * (x + 0.044715f * x * x * x); const float e = __expf(2.0f * z); const float t = 1.0f - 2.0f * __builtin_amdgcn_rcpf(e + 1.0f); return 0.5f * x * (1.0f + t); }
__device__ __forceinline__ float row_rstd(const float* ssq, int row) {
    const f32x4* p = (const f32x4*)(ssq + (size_t)row * 16); const f32x4 a = p[0], b = p[1], c = p[2], d = p[3];
    const float s = (((a.x + a.y) + (a.z + a.w)) + ((b.x + b.y) + (b.z + b.w))) + (((c.x + c.y) + (c.z + c.w)) + ((d.x + d.y) + (d.z + d.w)));
    return __builtin_amdgcn_rsqf(s * (1.0f / DM) + EPS);
}
__device__ __forceinline__ float wave_sum(float v) {
#pragma unroll
    for (int o = 1; o < 64; o <<= 1) v += __shfl_xor(v, o);
    return v;
}
#define LDS_WAIT() asm volatile("s_waitcnt lgkmcnt(0)" ::: "memory")
#define VM_WAIT() asm volatile("s_waitcnt vmcnt(0)" ::: "memory")

#define XB_TMO      128
#define XB_XCNT(j)  (256  + 64 * (j))
#define XB_XSUB(j)  (1280 + 64 * (j))
#define XB_XGEN(j)  (2304 + 64 * (j))
#define XB_TOP      3328
#define XB_TOPGEN   3392
#define XCD_BAR_WORDS 3456
#define XB_SPIN_CAP (1u << 22)
__device__ __forceinline__ unsigned xb_ld(unsigned* p)              { return __hip_atomic_load(p, __ATOMIC_RELAXED, __HIP_MEMORY_SCOPE_AGENT); }
__device__ __forceinline__ unsigned xb_add(unsigned* p, unsigned v) { return __hip_atomic_fetch_add(p, v, __ATOMIC_RELAXED, __HIP_MEMORY_SCOPE_AGENT); }
__device__ __forceinline__ unsigned xb_xcc_id() { return (unsigned)__builtin_amdgcn_s_getreg((3 << 11) | 20) & 0xFu; }
#define XB_SPIN(cond, bar) do { unsigned _sp = 0; while (cond) { __builtin_amdgcn_s_sleep(1); \
    if ((++_sp & 255u) == 0u) { if (xb_ld(&(bar)[XB_TMO])) break; if (_sp > XB_SPIN_CAP) { atomicAdd(&(bar)[XB_TMO], 1u); break; } } } } while (0)
struct XcdBarrier { unsigned* bar; unsigned x; volatile LAS unsigned* st; };
__device__ __forceinline__ XcdBarrier xcd_barrier_post(unsigned* bar, volatile LAS unsigned* st, int tid) {
    XcdBarrier b; b.bar = bar; b.x = xb_xcc_id(); b.st = st;
    if (tid == 0) (void)xb_add(&bar[XB_XCNT(b.x)], 1u);
    return b;
}
__device__ __forceinline__ void xcd_barrier_complete(unsigned* bar, unsigned x, unsigned& nloc, unsigned& nx) {
    const unsigned G = gridDim.x * gridDim.y * gridDim.z;
    unsigned sum, cnt, mine, sp = 0u;
    for (;;) {
        sum = 0u; cnt = 0u; mine = 0u;
#pragma unroll
        for (unsigned j = 0; j < 16; ++j) { const unsigned c = xb_ld(&bar[XB_XCNT(j)]); sum += c; cnt += (c > 0u) ? 1u : 0u; mine = (j == x) ? c : mine; }
        if (sum == G) break;
        __builtin_amdgcn_s_sleep(1);
        if ((++sp & 255u) == 0u) { if (xb_ld(&bar[XB_TMO])) break; if (sp > XB_SPIN_CAP) { atomicAdd(&bar[XB_TMO], 1u); break; } }
    }
    nloc = mine > 0u ? mine : 1u; nx = cnt > 0u ? cnt : 1u;
}
__device__ __forceinline__ void xcd_barrier(const XcdBarrier& b, int tid) {
    asm volatile("s_waitcnt vmcnt(0)" ::: "memory");
    __syncthreads();
    if (tid == 0) {
        unsigned* bar = b.bar;
        __builtin_amdgcn_s_waitcnt(0);
        unsigned nloc = b.st[0], nx = b.st[1];
        if (nloc == 0u) { xcd_barrier_complete(bar, b.x, nloc, nx); b.st[0] = nloc; b.st[1] = nx; }
        const unsigned old = xb_add(&bar[XB_XSUB(b.x)], 1u);
        const unsigned gen = old / nloc;
        if (old + 1u == (gen + 1u) * nloc) {
            __builtin_amdgcn_fence(__ATOMIC_RELEASE, "agent");
            asm volatile("s_waitcnt vmcnt(0)" ::: "memory");
            const unsigned og = xb_add(&bar[XB_TOP], 1u);
            const unsigned tg = og / nx;
            if (og + 1u == (tg + 1u) * nx) xb_add(&bar[XB_TOPGEN], 1u);
            else XB_SPIN(xb_ld(&bar[XB_TOPGEN]) == tg, bar);
            __builtin_amdgcn_fence(__ATOMIC_ACQUIRE, "agent");
            asm volatile("s_waitcnt vmcnt(0)" ::: "memory");
        } else {
            XB_SPIN(xb_ld(&bar[XB_TOPGEN]) == gen, bar);
            __builtin_amdgcn_fence(__ATOMIC_ACQUIRE, "agent");
            asm volatile("s_waitcnt vmcnt(0)" ::: "memory");
        }
    }
    __syncthreads();
}

namespace pg8 {
constexpr int BM = 256, BK = 64, HALF = 128, HTB = HALF * BK * 2, STAGE_BYTES = 8 * HTB, NXCD = 8, WGM = 8, GROWS = STAGE_BYTES;
__host__ __device__ __forceinline__ int lds_byte(int r, int c) { const int st = (r >> 4) * 2 + (c >> 5), rr = r & 15, cc = c & 31, ob = rr * 64 + cc * 2; return st * 1024 + (ob ^ (((ob >> 9) & 1) << 5)); }
__host__ __device__ __forceinline__ void stage_rc(int b, int& R, int& C) { const int st = b / 1024, sb = b % 1024, swz = sb ^ (((sb >> 9) & 1) << 5); R = (st >> 1) * 16 + swz / 64; C = (st & 1) * 32 + (swz % 64) / 2; }
__host__ __device__ __forceinline__ int perm32(int rho) { const int n = rho >> 4, i = rho & 15; return 8 * (i >> 2) + 4 * n + (i & 3); }

struct Unit { unsigned a, b; const int* rows; int pm, pn, x0, x1, bd; };
struct Gemm { int lda, ldb, kstepA, kstepB, K, gmax, ksplit; };

struct DenseOrder {
    unsigned A, Bt, tA, tB; int nM, nN, nwg, G, c;
    __device__ void init(size_t A_, size_t Bt_, int M, int N, int lda, int ldb, int G_, int c_) { A = (unsigned)A_; Bt = (unsigned)Bt_; tA = (unsigned)BM * lda * 2; tB = (unsigned)BM * ldb * 2; nM = M / BM; nN = N / BM; nwg = nM * nN; G = G_; c = c_; }
    __device__ bool next(int i, Unit& u) const {
        const long L = (long)i * G + c; if (L >= nwg) return false;
        int wgid = (int)L; { const int q = nwg / NXCD, r = nwg % NXCD, xcd = wgid % NXCD, off = wgid / NXCD; wgid = (xcd < r ? xcd * (q + 1) : r * (q + 1) + (xcd - r) * q) + off; }
        const int nig = WGM * nN, gid = wgid / nig, fm = gid * WGM, gsz = (nM - fm) < WGM ? (nM - fm) : WGM;
        u.pm = fm + ((wgid % nig) % gsz); u.pn = (wgid % nig) / gsz; u.a = A + (unsigned)u.pm * tA; u.b = Bt + (unsigned)u.pn * tB; u.rows = nullptr; u.x0 = 0; u.x1 = 0; u.bd = 0; return true;
    }
};

template <class Epi, class Sched, bool GATHER>
__device__ __forceinline__ void gemm_phase(LAS unsigned char* lds, const unsigned char* wsbase, const Gemm g, const Sched& S, const Epi& E, int tid_) {
    const __amdgpu_buffer_rsrc_t rs = __builtin_amdgcn_make_buffer_rsrc((void*)wsbase, 0, 0xFFFFFFFFu, 0x00020000);
    const int tid = tid_, wid = __builtin_amdgcn_readfirstlane(tid >> 6), lane = tid & 63, wr = wid >> 2, wc = wid & 3, fr = lane & 15, fq = lane >> 4;
    const int K = g.K, nt = K / BK;
    unsigned voffB[2], cvA0[2], cvA1[2];
#pragma unroll
    for (int i = 0; i < 2; ++i) { int R, C; stage_rc(tid * 16 + i * 8192, R, C); const int Rb = Epi::PERM ? ((R & ~31) + perm32(R & 31)) : R;
        voffB[i] = (unsigned)(Rb * g.ldb + C) * 2u; }
    const unsigned kstepA = (unsigned)g.kstepA, kstepB = (unsigned)g.kstepB;
    const unsigned hstepA = (unsigned)HALF * g.lda * 2, hstepB = (unsigned)HALF * g.ldb * 2;
    const unsigned ldsw = (unsigned)wid * 1024u;
    const int aoff = lds_byte(wr * 64 + fr, fq * 8), boff = lds_byte(wc * 32 + fr, fq * 8);
#define PG8_SA(b, h) (((b) * 2 + (h)) * HTB)
#define PG8_SB(b, h) ((4 + (b) * 2 + (h)) * HTB)
#define PG8_STAGE(bufoff, gbase, voff) do { _Pragma("unroll") for (int _i = 0; _i < 2; ++_i) \
        __builtin_amdgcn_raw_ptr_buffer_load_lds(rs, (LAS void*)(lds + (bufoff) + ldsw + _i * 8192), 16, (int)(voff)[_i], (int)(gbase), 0, 0); } while (0)
#define PG8_LDA(dst, b, h) do { _Pragma("unroll") for (int m = 0; m < 4; ++m) _Pragma("unroll") for (int k = 0; k < 2; ++k) dst[m][k] = *(const LAS bf16x8*)(lds + PG8_SA(b, h) + aoff + m * 2048 + k * 1024); } while (0)
#define PG8_LDB(dst, b, h) do { _Pragma("unroll") for (int n = 0; n < 2; ++n) _Pragma("unroll") for (int k = 0; k < 2; ++k) dst[n][k] = *(const LAS bf16x8*)(lds + PG8_SB(b, h) + boff + n * 2048 + k * 1024); } while (0)
#define PG8_MMA(ai, bj, At, Bt) do { __builtin_amdgcn_s_setprio(1); _Pragma("unroll") for (int m = 0; m < 4; ++m) _Pragma("unroll") for (int n = 0; n < 2; ++n) _Pragma("unroll") for (int k = 0; k < 2; ++k) \
        acc[ai][bj][m][n] = __builtin_amdgcn_mfma_f32_16x16x32_bf16(Bt[n][k], At[m][k], acc[ai][bj][m][n], 0, 0, 0); __builtin_amdgcn_s_setprio(0); } while (0)
#define PG8_WAIT_V(n) asm volatile("s_waitcnt vmcnt(" #n ")" ::: "memory")
#define PG8_WAIT_L(n) asm volatile("s_waitcnt lgkmcnt(" #n ")" ::: "memory")
#define PG8_BAR __builtin_amdgcn_s_barrier()
#define PG8_SCHED __builtin_amdgcn_sched_barrier(0)
#define PG8_STAGE_A(bufoff, gbase, half) do { if (half) PG8_STAGE(bufoff, gbase, cvA1); else PG8_STAGE(bufoff, gbase, cvA0); } while (0)
#define PG8_AOFF(u, o0, o1) do { if (GATHER) { _Pragma("unroll") for (int _i = 0; _i < 2; ++_i) { int sR_, sC_; stage_rc(tid * 16 + _i * 8192, sR_, sC_); \
            unsigned r0 = (unsigned)(u).rows[sR_], r1 = (unsigned)(u).rows[HALF + sR_]; r0 = r0 <= (unsigned)g.gmax ? r0 : 0u; r1 = r1 <= (unsigned)g.gmax ? r1 : 0u; \
            o0[_i] = (r0 * (unsigned)g.lda + (unsigned)sC_) * 2u; o1[_i] = (r1 * (unsigned)g.lda + (unsigned)sC_) * 2u; } } \
        else { _Pragma("unroll") for (int _i = 0; _i < 2; ++_i) { int sR_, sC_; stage_rc(tid * 16 + _i * 8192, sR_, sC_); o0[_i] = (unsigned)(sR_ * g.lda + sC_) * 2u; o1[_i] = o0[_i] + (unsigned)hstepA; } } } while (0)
    Unit cur, nxt; int ui = 0;
    if (!S.next(0, cur)) return;
    f32x4 acc[2][2][4][2];
#pragma unroll
    for (int a = 0; a < 2; ++a)
#pragma unroll
        for (int b = 0; b < 2; ++b)
#pragma unroll
            for (int m = 0; m < 4; ++m)
#pragma unroll
                for (int n = 0; n < 2; ++n) acc[a][b][m][n] = (f32x4){0.f, 0.f, 0.f, 0.f};
    bf16x8 At[4][2], B0[2][2], B1[2][2];
    unsigned cA = cur.a, cB = cur.b;
    PG8_AOFF(cur, cvA0, cvA1);
    if (GATHER) { __builtin_amdgcn_s_waitcnt(0x0F70); asm volatile("" ::: "memory"); }
    PG8_STAGE(PG8_SB(0, 0), cB, voffB); PG8_STAGE_A(PG8_SA(0, 0), cA, 0); PG8_STAGE(PG8_SB(0, 1), cB + hstepB, voffB); PG8_STAGE_A(PG8_SA(0, 1), cA, 1);
    if (wr == 1) PG8_BAR;
    PG8_WAIT_V(4); PG8_BAR;
    PG8_STAGE(PG8_SB(1, 0), cB + kstepB, voffB); PG8_STAGE_A(PG8_SA(1, 0), cA + kstepA, 0); PG8_STAGE(PG8_SB(1, 1), cB + hstepB + kstepB, voffB);
    PG8_WAIT_V(6); PG8_BAR;
    for (;;) {
        const bool has_next = S.next(ui + 1, nxt);
        const unsigned nA = has_next ? nxt.a : cA, nB = has_next ? nxt.b : cB;
        for (int t = 0; t < nt; t += 2) {
            const bool last = (t == nt - 2);
            unsigned nvA0[2], nvA1[2];
            if (GATHER) { if (last && has_next) {
#pragma unroll
                for (int _i = 0; _i < 2; ++_i) { int sR_, sC_; stage_rc(tid * 16 + _i * 8192, sR_, sC_);
                    unsigned r0 = (unsigned)((const LAS int*)(lds + GROWS))[sR_], r1 = (unsigned)((const LAS int*)(lds + GROWS))[HALF + sR_]; r0 = r0 <= (unsigned)g.gmax ? r0 : 0u; r1 = r1 <= (unsigned)g.gmax ? r1 : 0u;
                    nvA0[_i] = (r0 * (unsigned)g.lda + (unsigned)sC_) * 2u; nvA1[_i] = (r1 * (unsigned)g.lda + (unsigned)sC_) * 2u; } } }
            const unsigned a1 = cA + (unsigned)(t + 1) * kstepA;
            const unsigned a2 = last ? nA : cA + (unsigned)(t + 2) * kstepA, b2 = last ? nB : cB + (unsigned)(t + 2) * kstepB + ((t + 2) >= g.ksplit ? (unsigned)cur.bd : 0u);
            const unsigned a3 = a2 + kstepA, b3 = last ? nB + kstepB : cB + (unsigned)(t + 3) * kstepB + ((t + 3) >= g.ksplit ? (unsigned)cur.bd : 0u);
            PG8_LDB(B0, 0, 0); PG8_SCHED; PG8_LDA(At, 0, 0); PG8_STAGE_A(PG8_SA(1, 1), a1, 1);
            if (GATHER) { if (last && has_next) {
#pragma unroll
                for (int i = 0; i < 2; ++i) { cvA0[i] = nvA0[i]; cvA1[i] = nvA1[i]; } } }
            PG8_WAIT_L(8); PG8_BAR; PG8_WAIT_L(0); PG8_MMA(0, 0, At, B0); PG8_BAR; PG8_SCHED;
            PG8_LDB(B1, 0, 1); PG8_STAGE(PG8_SB(0, 0), b2, voffB);
            PG8_BAR; PG8_WAIT_L(0); PG8_MMA(0, 1, At, B1); PG8_BAR;
            PG8_LDA(At, 0, 1); PG8_STAGE_A(PG8_SA(0, 0), a2, 0);
            PG8_BAR; PG8_WAIT_L(0); PG8_MMA(1, 0, At, B0); PG8_BAR; PG8_SCHED;
            PG8_STAGE(PG8_SB(0, 1), b2 + hstepB, voffB);
            PG8_WAIT_V(6); PG8_BAR; PG8_MMA(1, 1, At, B1); PG8_BAR;
            PG8_LDB(B0, 1, 0); PG8_SCHED; PG8_LDA(At, 1, 0); PG8_STAGE_A(PG8_SA(0, 1), a2, 1);
            if (GATHER) { if (has_next && t == nt - 6)
                __builtin_amdgcn_raw_ptr_buffer_load_lds(rs, (LAS void*)(lds + GROWS), 16, lane * 16, (int)(unsigned)((const unsigned char*)nxt.rows - wsbase), 0, 0); }
            PG8_WAIT_L(8); PG8_BAR; PG8_WAIT_L(0); PG8_MMA(0, 0, At, B0); PG8_BAR; PG8_SCHED;
            PG8_LDB(B1, 1, 1); PG8_STAGE(PG8_SB(1, 0), b3, voffB);
            PG8_BAR; PG8_WAIT_L(0); PG8_MMA(0, 1, At, B1); PG8_BAR;
            PG8_LDA(At, 1, 1); PG8_STAGE_A(PG8_SA(1, 0), a3, 0);
            PG8_BAR; PG8_WAIT_L(0); PG8_MMA(1, 0, At, B0); PG8_BAR; PG8_SCHED;
            PG8_STAGE(PG8_SB(1, 1), b3 + hstepB, voffB);
            if (GATHER && has_next && t == nt - 6) { PG8_WAIT_V(7); } else { PG8_WAIT_V(6); }
            PG8_BAR; PG8_MMA(1, 1, At, B1); PG8_BAR;
        }
        if constexpr (!Epi::AFTER_DRAIN) { E(acc, cur, wr, wc, fr, fq); }
        if (!has_next) break;
#pragma unroll
        for (int a = 0; a < 2; ++a)
#pragma unroll
            for (int b = 0; b < 2; ++b)
#pragma unroll
                for (int m = 0; m < 4; ++m)
#pragma unroll
                    for (int n = 0; n < 2; ++n) acc[a][b][m][n] = (f32x4){0.f, 0.f, 0.f, 0.f};
        cur = nxt; cA = nA; cB = nB; ++ui;
    }
    PG8_WAIT_V(0);
    if (wr == 0) PG8_BAR;
    PG8_BAR;
    if constexpr (Epi::AFTER_DRAIN) { E.fused(acc, cur, wr, wc, fr, fq, lds, wid, lane); }
#undef PG8_SA
#undef PG8_SB
#undef PG8_STAGE
#undef PG8_LDA
#undef PG8_LDB
#undef PG8_MMA
#undef PG8_WAIT_V
#undef PG8_WAIT_L
#undef PG8_BAR
#undef PG8_SCHED
#undef PG8_AOFF
#undef PG8_STAGE_A
}
}
using pg8::Unit;
typedef f32x4 AccT[2][2][4][2];

struct Args { const void* in[37]; float* out; unsigned char* ws; int ph_lo, ph_hi; };
#define GAS __attribute__((address_space(1)))
struct Frame {
    LAS unsigned char* lds; int tid, lane, wave, G, bx, z;
    GAS unsigned char* ws; GAS float* out; const void* const* in;
};
#define WSP(T, off) ((T*)(GAS T*)(F.ws + (off)))
#define INF(i) ((const float*)F.in[(i) + F.z])


struct EpiPlainBf16 {
    static constexpr bool PERM = true, AFTER_DRAIN = false;
    bf16_t* O0; bf16_t* O1;
    __device__ __forceinline__ void operator()(const AccT& acc, const Unit& u, int wr, int wc, int fr, int fq) const {
        const int ldc = u.x0 ? 2048 : 1024; bf16_t* base = (u.x0 ? O1 : O0) + (size_t)u.x1 * (2048 * 1024);
        const int row0 = u.pm * 256 + wr * 64 + fr, col0 = u.pn * 256 + wc * 32 + 8 * fq;
#pragma unroll
        for (int ai = 0; ai < 2; ++ai)
#pragma unroll
            for (int m = 0; m < 4; ++m) { bf16_t* rowp = base + (size_t)(row0 + ai * 128 + m * 16) * ldc + col0;
#pragma unroll
                for (int bj = 0; bj < 2; ++bj) { const f32x4 v0 = acc[ai][bj][m][0], v1 = acc[ai][bj][m][1];
                    u32x4 w; w.x = cvt_pk_bf16(v0[0], v0[1]); w.y = cvt_pk_bf16(v0[2], v0[3]); w.z = cvt_pk_bf16(v1[0], v1[1]); w.w = cvt_pk_bf16(v1[2], v1[3]);
                    *(u32x4*)(rowp + bj * 128) = w; } }
    }
};

struct EpiRowScale {
    static constexpr bool PERM = true, AFTER_DRAIN = false;
    bf16_t* O; int ldc; const float* ssq; const float* rope; int rope_pn;
    __device__ __forceinline__ void operator()(const AccT& acc, const Unit& u, int wr, int wc, int fr, int fq) const {
        const int row0 = u.pm * 256 + wr * 64 + fr, col0 = u.pn * 256 + wc * 32 + 8 * fq;
        const bool do_rope = (u.pn == rope_pn) && ((wc & 1) == 0);
        f32x4 qs[2][4];
#pragma unroll
        for (int ai = 0; ai < 2; ++ai)
#pragma unroll
            for (int m = 0; m < 4; ++m) qs[ai][m] = *(const f32x4*)((const char*)ssq + ((unsigned)(row0 + ai * 128 + m * 16) * 64u + (unsigned)fq * 16u));
        float rsv[2][4];
#pragma unroll
        for (int ai = 0; ai < 2; ++ai)
#pragma unroll
            for (int m = 0; m < 4; ++m) { const f32x4 q = qs[ai][m]; float sm = (q.x + q.y) + (q.z + q.w); sm += __shfl_xor(sm, 16); sm += __shfl_xor(sm, 32); rsv[ai][m] = __builtin_amdgcn_rsqf(sm * (1.0f / DM) + EPS); }
#pragma unroll
        for (int ai = 0; ai < 2; ++ai)
#pragma unroll
            for (int m = 0; m < 4; ++m) { const int row = row0 + ai * 128 + m * 16; const float rs = rsv[ai][m]; char* rowp = (char*)O + ((unsigned)row * (unsigned)ldc + (unsigned)col0) * 2u;
                f32x4 cs0 = {0.f, 0.f, 0.f, 0.f}, cs1 = cs0, sn0 = cs0, sn1 = cs0;
                if (do_rope) { const f32x4* rp = (const f32x4*)(rope + (size_t)row * 16); cs0 = rp[0]; cs1 = rp[1]; sn0 = rp[2]; sn1 = rp[3]; }
#pragma unroll
                for (int bj = 0; bj < 2; ++bj) { f32x4 v0 = acc[ai][bj][m][0] * rs, v1 = acc[ai][bj][m][1] * rs;
                    if (do_rope) {
                        f32x4 p0, p1;
#pragma unroll
                        for (int j = 0; j < 4; ++j) { p0[j] = __shfl_xor(v0[j], 16); p1[j] = __shfl_xor(v1[j], 16); }
                        if (fq == 0) { v0 = v0 * cs0 - p0 * sn0; v1 = v1 * cs1 - p1 * sn1; }
                        else if (fq == 1) { v0 = v0 * cs0 + p0 * sn0; v1 = v1 * cs1 + p1 * sn1; }
                    }
                    u32x4 w; w.x = cvt_pk_bf16(v0[0], v0[1]); w.y = cvt_pk_bf16(v0[2], v0[3]); w.z = cvt_pk_bf16(v1[0], v1[1]); w.w = cvt_pk_bf16(v1[2], v1[3]);
                    *(u32x4*)(rowp + bj * 256) = w; } }
    }
};

struct EpiColScale {
    static constexpr bool PERM = true, AFTER_DRAIN = false;
    bf16_t* O; const float* ssq;
    __device__ __forceinline__ void operator()(const AccT& acc, const Unit& u, int wr, int wc, int fr, int fq) const {
        const int row0 = u.pm * 256 + wr * 64 + fr, col0 = u.pn * 256 + wc * 32 + 8 * fq;
        const int ln = fr + 16 * fq; const float mine = row_rstd(ssq, u.pn * 256 + wc * 32 + (ln >> 5) * 128 + (ln & 31));
#pragma unroll
        for (int bj = 0; bj < 2; ++bj) { float rs[8];
#pragma unroll
            for (int j = 0; j < 8; ++j) rs[j] = __shfl(mine, bj * 32 + 8 * fq + j);
#pragma unroll
            for (int ai = 0; ai < 2; ++ai)
#pragma unroll
                for (int m = 0; m < 4; ++m) { const f32x4 v0 = acc[ai][bj][m][0], v1 = acc[ai][bj][m][1];
                    u32x4 w; w.x = cvt_pk_bf16(v0[0] * rs[0], v0[1] * rs[1]); w.y = cvt_pk_bf16(v0[2] * rs[2], v0[3] * rs[3]); w.z = cvt_pk_bf16(v1[0] * rs[4], v1[1] * rs[5]); w.w = cvt_pk_bf16(v1[2] * rs[6], v1[3] * rs[7]);
                    *(u32x4*)((char*)O + ((unsigned)(row0 + ai * 128 + m * 16) * (unsigned)NTOK + (unsigned)(col0 + bj * 128)) * 2u) = w; } }
    }
};

struct EpiResid {
    static constexpr bool PERM = true, AFTER_DRAIN = false;
    bf16_t* hb; float* ssq;
    __device__ __forceinline__ void operator()(const AccT& acc, const Unit& u, int wr, int wc, int fr, int fq) const {
        const int row0 = u.pm * 256 + wr * 64 + fr, col0 = u.pn * 256 + wc * 32 + 8 * fq;
        u32x4 bsa[2][4][2];
#pragma unroll
        for (int ai = 0; ai < 2; ++ai)
#pragma unroll
            for (int m = 0; m < 4; ++m) { const unsigned off = ((unsigned)(row0 + ai * 128 + m * 16) * DM + (unsigned)col0) * 2u;
#pragma unroll
                for (int bj = 0; bj < 2; ++bj) bsa[ai][m][bj] = *(const u32x4*)((const char*)hb + off + bj * 256); }
#pragma unroll
        for (int ai = 0; ai < 2; ++ai) {
#pragma unroll
            for (int m = 0; m < 4; ++m) { const int row = row0 + ai * 128 + m * 16; const unsigned off = ((unsigned)row * DM + (unsigned)col0) * 2u; float ss; f32x2 sp = {0.f, 0.f};
#pragma unroll
                for (int bj = 0; bj < 2; ++bj) { const f32x4 a0 = acc[ai][bj][m][0], a1 = acc[ai][bj][m][1]; const u32x4 b4 = bsa[ai][m][bj];
                    const float o0 = bflo(b4.x) + a0[0], o1 = bfhi(b4.x) + a0[1], o2 = bflo(b4.y) + a0[2], o3 = bfhi(b4.y) + a0[3], o4 = bflo(b4.z) + a1[0], o5 = bfhi(b4.z) + a1[1], o6 = bflo(b4.w) + a1[2], o7 = bfhi(b4.w) + a1[3];
                    u32x4 w; w.x = cvt_pk_bf16(o0, o1); w.y = cvt_pk_bf16(o2, o3); w.z = cvt_pk_bf16(o4, o5); w.w = cvt_pk_bf16(o6, o7); *(u32x4*)((char*)hb + off + bj * 256) = w;
                    const f32x2 p01 = {o0, o1}, p23 = {o2, o3}, p45 = {o4, o5}, p67 = {o6, o7}; sp = p01 * p01 + sp; sp = p23 * p23 + sp; sp = p45 * p45 + sp; sp = p67 * p67 + sp; }
                ss = sp.x + sp.y; ss += __shfl_xor(ss, 16); ss += __shfl_xor(ss, 32);
                if (fq == 0) *(float*)((char*)ssq + ((unsigned)row * 16u + (unsigned)(u.pn * 4 + wc)) * 4u) = ss; }
            asm volatile("" ::: "memory"); }
    }
};

struct EpiOddIn {
    static constexpr bool PERM = true, AFTER_DRAIN = false;
    bf16_t* Bg; bf16_t* CV; const float* ssq;
    __device__ __forceinline__ void operator()(const AccT& acc, const Unit& u, int wr, int wc, int fr, int fq) const {
        const int row0 = u.pm * 256 + wr * 64 + fr;
        f32x4 qs[2][4];
#pragma unroll
        for (int ai = 0; ai < 2; ++ai)
#pragma unroll
            for (int m = 0; m < 4; ++m) qs[ai][m] = *(const f32x4*)((const char*)ssq + ((unsigned)(row0 + ai * 128 + m * 16) * 64u + (unsigned)fq * 16u));
        float rsv[2][4];
#pragma unroll
        for (int ai = 0; ai < 2; ++ai)
#pragma unroll
            for (int m = 0; m < 4; ++m) { const f32x4 q = qs[ai][m]; float sm = (q.x + q.y) + (q.z + q.w); sm += __shfl_xor(sm, 16); sm += __shfl_xor(sm, 32); rsv[ai][m] = __builtin_amdgcn_rsqf(sm * (1.0f / DM) + EPS); }
#pragma unroll
        for (int ai = 0; ai < 2; ++ai)
#pragma unroll
            for (int m = 0; m < 4; ++m) { const int row = row0 + ai * 128 + m * 16; const float rs = rsv[ai][m];
                if (u.pn < 8) { const float r2 = rs * rs; const f32x4 o0 = acc[ai][0][m][0] * acc[ai][1][m][0] * r2, o1 = acc[ai][0][m][1] * acc[ai][1][m][1] * r2;
                    u32x4 w; w.x = cvt_pk_bf16(o0[0], o0[1]); w.y = cvt_pk_bf16(o0[2], o0[3]); w.z = cvt_pk_bf16(o1[0], o1[1]); w.w = cvt_pk_bf16(o1[2], o1[3]);
                    *(u32x4*)((char*)CV + ((unsigned)row * DM + (unsigned)(u.pn * 128 + wc * 32 + 8 * fq)) * 2u) = w;
                } else {
#pragma unroll
                    for (int bj = 0; bj < 2; ++bj) { const f32x4 o0 = acc[ai][bj][m][0] * rs, o1 = acc[ai][bj][m][1] * rs;
                        u32x4 w; w.x = cvt_pk_bf16(o0[0], o0[1]); w.y = cvt_pk_bf16(o0[2], o0[3]); w.z = cvt_pk_bf16(o1[0], o1[1]); w.w = cvt_pk_bf16(o1[2], o1[3]);
                        *(u32x4*)((char*)Bg + ((unsigned)row * DM + (unsigned)((u.pn - 8) * 256 + bj * 128 + wc * 32 + 8 * fq)) * 2u) = w; }
                } }
    }
};

struct EpiGateUp {
    static constexpr bool PERM = true, AFTER_DRAIN = false;
    bf16_t* hmid; const float* ssq; const float* rw;
    __device__ __forceinline__ void operator()(const AccT& acc, const Unit& u, int wr, int wc, int fr, int fq) const {
        int tok[2][4]; float rs[2][4], wg[2][4];
#pragma unroll
        for (int ai = 0; ai < 2; ++ai)
#pragma unroll
            for (int m = 0; m < 4; ++m) { const int r = ai * 128 + wr * 64 + m * 16 + fr; tok[ai][m] = (r < u.x0) ? u.rows[r] : -1; }
#pragma unroll
        for (int ai = 0; ai < 2; ++ai)
#pragma unroll
            for (int m = 0; m < 4; ++m) { const unsigned t = tok[ai][m] >= 0 ? (unsigned)tok[ai][m] : 0u; rs[ai][m] = *(const float*)((const char*)ssq + t * 4u); wg[ai][m] = *(const float*)((const char*)rw + (t * 2u + (unsigned)u.pm) * 4u); }
        __builtin_amdgcn_s_waitcnt(0x0F70); asm volatile("" ::: "memory");
#pragma unroll
        for (int ai = 0; ai < 2; ++ai)
#pragma unroll
            for (int m = 0; m < 4; ++m) { const int r = ai * 128 + wr * 64 + m * 16 + fr;
                if (tok[ai][m] >= 0) { const float rsv = rs[ai][m], k1 = rsv * rsv * wg[ai][m], k2 = -1.4426950408889634f * rsv;
                    float o[8];
#pragma unroll
                    for (int n = 0; n < 2; ++n) { const f32x4 g4 = acc[ai][0][m][n]; const f32x4 gu = g4 * acc[ai][1][m][n] * k1, t4 = g4 * k2;
#pragma unroll
                        for (int j = 0; j < 4; ++j) o[4 * n + j] = gu[j] * __builtin_amdgcn_rcpf(1.0f + fast_exp2(t4[j])); }
                    u32x4 w; w.x = cvt_pk_bf16(o[0], o[1]); w.y = cvt_pk_bf16(o[2], o[3]); w.z = cvt_pk_bf16(o[4], o[5]); w.w = cvt_pk_bf16(o[6], o[7]);
                    *(u32x4*)((char*)hmid + ((unsigned)(u.x1 + r) * 1024u + (unsigned)(u.pm * 512 + u.pn * 128 + wc * 32 + 8 * fq)) * 2u) = w; } }
    }
};

template <bool FINAL> struct EpiDown {
    static constexpr bool PERM = true, AFTER_DRAIN = false;
    bf16_t* hb; float* ssq; const float* rw; int pass;
    __device__ __forceinline__ void operator()(const AccT& acc, const Unit& u, int wr, int wc, int fr, int fq) const {
        const int col0 = u.pn * 256 + wc * 32 + 8 * fq;
        int tok[2][4];
#pragma unroll
        for (int ai = 0; ai < 2; ++ai)
#pragma unroll
            for (int m = 0; m < 4; ++m) { const int r = ai * 128 + wr * 64 + m * 16 + fr; tok[ai][m] = (r < u.x0) ? u.rows[r] : -1; }
#pragma unroll
        for (int ai = 0; ai < 2; ++ai) {
        u32x4 bs[4][2];
#pragma unroll
            for (int m = 0; m < 4; ++m) { const bool valid = tok[ai][m] >= 0; const unsigned off = ((unsigned)(valid ? tok[ai][m] : 0) * DM + (unsigned)col0) * 2u;
#pragma unroll
                for (int bj = 0; bj < 2; ++bj) bs[m][bj] = valid ? *(const u32x4*)((const char*)hb + off + bj * 256) : (u32x4){0u, 0u, 0u, 0u}; }
#pragma unroll
            for (int m = 0; m < 4; ++m) { const bool valid = tok[ai][m] >= 0; const unsigned off = ((unsigned)(valid ? tok[ai][m] : 0) * DM + (unsigned)col0) * 2u; float ss = 0.f;
                if (valid) {
#pragma unroll
                    for (int bj = 0; bj < 2; ++bj) { const f32x4 a0 = acc[ai][bj][m][0], a1 = acc[ai][bj][m][1]; const u32x4 b4 = bs[m][bj];
                        const float o0 = bflo(b4.x) + a0[0], o1 = bfhi(b4.x) + a0[1], o2 = bflo(b4.y) + a0[2], o3 = bfhi(b4.y) + a0[3], o4 = bflo(b4.z) + a1[0], o5 = bfhi(b4.z) + a1[1], o6 = bflo(b4.w) + a1[2], o7 = bfhi(b4.w) + a1[3];
                        u32x4 w; w.x = cvt_pk_bf16(o0, o1); w.y = cvt_pk_bf16(o2, o3); w.z = cvt_pk_bf16(o4, o5); w.w = cvt_pk_bf16(o6, o7); *(u32x4*)((char*)hb + off + bj * 256) = w;
                        if (FINAL) { const f32x2 p01 = {o0, o1}, p23 = {o2, o3}, p45 = {o4, o5}, p67 = {o6, o7}; f32x2 sp = p01 * p01; sp = p23 * p23 + sp; sp = p45 * p45 + sp; sp = p67 * p67 + sp; ss += sp.x + sp.y; } }
                }
                if (FINAL) { ss += __shfl_xor(ss, 16); ss += __shfl_xor(ss, 32); if (valid && fq == 0) *(float*)((char*)ssq + ((unsigned)tok[ai][m] * 16u + (unsigned)(u.pn * 4 + wc)) * 4u) = ss; } }
            asm volatile("" ::: "memory"); }
    }
};

struct Job { const float* src; int ld, K, ncols; const float* gain; bf16_t* dst; int ldd; };
__device__ __forceinline__ void transpose_item(const Job& J, LAS float* scr, int item, int lane) {
    const int nblk = (J.ncols + 31) / 32, kb = item / nblk, nb = item % nblk, k0 = 64 * kb, n0 = 32 * nb;
    const int nn = lane & 31; const bool nv = (n0 + nn) < J.ncols;
#pragma unroll 8
    for (int i = 0; i < 32; ++i) { const int kk = 2 * i + (lane >> 5); float v = nv ? J.src[(size_t)(k0 + kk) * J.ld + n0 + nn] : 0.f; if (J.gain) v *= J.gain[k0 + kk]; scr[kk * 33 + nn] = v; }
    LDS_WAIT(); asm volatile("" ::: "memory");
    const int c = lane & 7;
#pragma unroll
    for (int j = 0; j < 4; ++j) { const int n = (lane >> 3) + 8 * j; const LAS float* s = scr + (8 * c) * 33 + n;
        u32x4 o; o.x = cvt_pk_bf16(s[0 * 33], s[1 * 33]); o.y = cvt_pk_bf16(s[2 * 33], s[3 * 33]); o.z = cvt_pk_bf16(s[4 * 33], s[5 * 33]); o.w = cvt_pk_bf16(s[6 * 33], s[7 * 33]);
        if (n0 + n < J.ncols) *(u32x4*)(J.dst + (size_t)(n0 + n) * J.ldd + k0 + 8 * c) = o; }
    LDS_WAIT(); asm volatile("" ::: "memory");
}
__device__ __forceinline__ bool job_wide(const Job& J) { return ((J.ncols & 63) == 0) && ((J.K & 63) == 0); }
__device__ __forceinline__ int job_items(const Job& J) { return job_wide(J) ? (J.K >> 6) * (J.ncols >> 6) : (J.K / 64) * ((J.ncols + 31) / 32); }
__device__ __forceinline__ void transpose_item64(const Job& J, LAS float* scr, int item, int lane) {
    const int nblk = J.ncols >> 6, kb = item / nblk, nb = item - kb * nblk, k0 = 64 * kb, n0 = 64 * nb;
    const int r4 = lane >> 4, c4 = lane & 15;
    f32x4 v[16];
#pragma unroll
    for (int i = 0; i < 16; ++i) v[i] = *(const f32x4*)(J.src + (size_t)(k0 + 4 * i + r4) * J.ld + n0 + 4 * c4);
    if (J.gain) {
#pragma unroll
        for (int i = 0; i < 16; ++i) v[i] *= J.gain[k0 + 4 * i + r4]; }
#pragma unroll
    for (int i = 0; i < 16; ++i) { const int kk = 4 * i + r4;
#pragma unroll
        for (int j = 0; j < 4; ++j) scr[(4 * c4 + j) * 65 + kk] = v[i][j]; }
    LDS_WAIT(); asm volatile("" ::: "memory");
    const int c = lane & 7;
#pragma unroll
    for (int j = 0; j < 8; ++j) { const int n = (lane >> 3) + 8 * j; const LAS float* sp = scr + n * 65 + 8 * c;
        u32x4 o; o.x = cvt_pk_bf16(sp[0], sp[1]); o.y = cvt_pk_bf16(sp[2], sp[3]); o.z = cvt_pk_bf16(sp[4], sp[5]); o.w = cvt_pk_bf16(sp[6], sp[7]);
        *(u32x4*)(J.dst + (size_t)(n0 + n) * J.ldd + k0 + 8 * c) = o; }
    LDS_WAIT(); asm volatile("" ::: "memory");
}
__device__ __forceinline__ void run_item(const Job& J, LAS float* scr, int item, int lane) { if (job_wide(J)) transpose_item64(J, scr, item, lane); else transpose_item(J, scr, item, lane); }
__device__ __forceinline__ void run_job(Frame& F, const Job& J, int& base) {
    LAS float* scr = (LAS float*)(F.lds + F.wave * 16640);
    const int gw = F.bx * 8 + F.wave, NGW = F.G * 8;
    const int nitems = job_items(J);
    int first = gw - base % NGW; if (first < 0) first += NGW;
    for (int it = first; it < nitems; it += NGW) run_item(J, scr, it, F.lane);
    base += nitems;
}
constexpr int NJOBS_P0 = 118;
__device__ __forceinline__ void p0_job(Frame& F, int j, Job& J) {
    J.gain = nullptr; J.ld = DM; J.K = DM; J.ncols = DM; J.ldd = DM;
    if (j < 54) { const int e = j / 27, q = j % 27; const float* win = INF(8) + (size_t)e * DM * EPROJ; const float* gmix = INF(3) + (size_t)(2 * e) * DM;
        bf16_t* wa = WSP(bf16_t, WS_W_EINA) + (size_t)e * PA_N * DM; bf16_t* wb = WSP(bf16_t, WS_W_EINB) + (size_t)e * PB_N * DM;
        if (q < 6) { J.ld = EPROJ; J.gain = gmix;
            const int sc = q == 0 ? 0 : q == 1 ? 1792 : q == 2 ? 2048 : q == 3 ? 1920 : q == 4 ? 2176 : 2304;
            const int nc = q == 0 ? 1792 : q == 5 ? 24 : 128;
            const int dr = q == 0 ? 0 : q == 1 ? 1792 : q == 2 ? 1920 : q == 3 ? 0 : q == 4 ? 128 : 256;
            J.src = win + sc; J.ncols = nc; J.dst = (q < 3 ? wa : wb) + (size_t)dr * DM; }
        else if (q == 6) { J.src = INF(9) + (size_t)e * DM * DM; J.dst = WSP(bf16_t, WS_W_EOUT) + (size_t)e * DM * DM; }
        else if (q < 23) { const int ri = (q - 7) / 8, k = (q - 7) % 8; J.src = INF(ri ? 14 : 12) + (size_t)(e * 8 + k) * 4096; J.ld = 64; J.K = 64; J.ncols = 64; J.ldd = 64;
            J.dst = WSP(bf16_t, WS_W_LRU) + (size_t)((e * 2 + ri) * 8 + k) * 4096; }
        else { const int kv = (q - 23) / 2, hf = (q - 23) % 2; J.src = INF(kv ? 21 : 18) + (size_t)e * 2048 * 128 + (size_t)hf * 1024 * 128; J.ld = 128; J.K = 1024; J.ncols = 128; J.ldd = 1024;
            J.dst = WSP(bf16_t, WS_W_CMP1) + (size_t)((e * 2 + kv) * 256 + hf * 128) * 1024; }
    } else if (j < 90) { const int o = (j - 54) / 18, q = (j - 54) % 18; const float* win = INF(23) + (size_t)o * DM * 3072; bf16_t* wo = WSP(bf16_t, WS_W_OIN) + (size_t)o * 3072 * DM;
        J.gain = INF(3) + (size_t)(2 * o + 1) * DM; J.ld = 3072;
        if (q < 8) { J.src = win + 1024 + 128 * q; J.ncols = 128; J.dst = wo + (size_t)(256 * q) * DM; }
        else if (q < 16) { J.src = win + 2048 + 128 * (q - 8); J.ncols = 128; J.dst = wo + (size_t)(256 * (q - 8) + 128) * DM; }
        else if (q == 16) { J.src = win; J.ncols = 1024; J.dst = wo + (size_t)2048 * DM; }
        else { J.gain = nullptr; J.ld = DM; J.src = INF(25) + (size_t)o * DM * DM; J.dst = WSP(bf16_t, WS_W_OOUT) + (size_t)o * DM * DM; }
    } else if (j < 114) { const int l = (j - 90) / 6, q = (j - 90) % 6; const size_t lo = (size_t)l * DM * DM;
        if (q == 0) { J.src = INF(26) + lo; J.gain = INF(4) + l * DM; J.dst = WSP(bf16_t, WS_W_XQ) + lo; }
        else if (q == 1) { J.src = INF(27) + lo; J.gain = INF(5) + l * DM; J.dst = WSP(bf16_t, WS_W_XK) + lo; }
        else if (q == 2) { J.src = INF(28) + lo; J.gain = INF(5) + l * DM; J.dst = WSP(bf16_t, WS_W_XV) + lo; }
        else if (q == 3) { J.src = INF(29) + lo; J.dst = WSP(bf16_t, WS_W_XO) + lo; }
        else if (q == 4) { J.src = INF(30) + (size_t)l * DM * 4; J.ld = 4; J.ncols = 4; J.gain = INF(6) + l * DM; J.dst = WSP(bf16_t, WS_W_RT) + (size_t)l * 32 * DM; }
        else { J.src = INF(32) + (size_t)l * DM * 16; J.ld = 16; J.ncols = 16; J.gain = INF(6) + l * DM; J.dst = WSP(bf16_t, WS_W_RT) + (size_t)(l * 32 + 4) * DM; }
    } else { const int q = j - 114, e = q / 2, kv = q % 2; J.src = INF(kv ? 22 : 19) + (size_t)e * 128 * 64; J.ld = 64; J.K = 128; J.ncols = 64; J.ldd = 128;
        J.dst = WSP(bf16_t, WS_W_CMP2) + (size_t)(e * 2 + kv) * 64 * 128; }
}
__device__ __forceinline__ void moe_job(Frame& F, int l, int j, Job& J) {
    const int e = j / 9, q = j % 9; const size_t eo = (size_t)(l * 16 + e) * DM * 512;
    if (q < 8) { const int pn = q & 3, up = q >> 2; J.src = INF(up ? 35 : 34) + eo + 128 * pn; J.ld = 512; J.K = DM; J.ncols = 128; J.gain = INF(6) + l * DM; J.ldd = DM;
        J.dst = (bf16_t*)(F.ws + ((l & 1) ? WS_MOE_GU2 : WS_MOE_GU)) + (size_t)e * DM * DM + (size_t)(256 * pn + 128 * up) * DM; }
    else { J.src = INF(36) + eo; J.ld = DM; J.K = 512; J.ncols = DM; J.gain = nullptr; J.ldd = 512; J.dst = (bf16_t*)(F.ws + ((l & 1) ? WS_MOE_D2 : WS_MOE_D)) + (size_t)e * DM * 512; }
}

constexpr int MOE_ITEMS = 16 * 384;
__device__ __forceinline__ void moe_convert_drain(Frame& F, int layer) {
    if (layer >= DEPTH) return;
    LAS int* qs = (LAS int*)(F.lds + LDS_MISC + 1024);
    LAS float* scr = (LAS float*)(F.lds + F.wave * 16640);
    unsigned* qh = WSP(unsigned, WS_CTL) + CW_Q + layer * 16;
    for (;;) {
        if (F.tid == 0) qs[0] = (int)atomicAdd(qh, 32u);
        __syncthreads();
        const int base = qs[0];
        __syncthreads();
        if (base >= MOE_ITEMS) break;
#pragma unroll 1
        for (int k = 0; k < 4; ++k) { const int idx = base + F.wave * 4 + k; if (idx >= MOE_ITEMS) break;
            const int e = idx / 384, r = idx - e * 384; const int q = r < 256 ? (r >> 5) : 8, item = r < 256 ? (r & 31) : (r - 256);
            Job J; moe_job(F, layer, e * 9 + q, J); transpose_item64(J, scr, item, F.lane); }
    }
}

__device__ __forceinline__ void phase_prologue(Frame& F) {
    const int gw = F.bx * 8 + F.wave, NGW = F.G * 8, gt = F.bx * 512 + F.tid, NGT = F.G * 512;
    { int base = 0; for (int j = 0; j < NJOBS_P0; ++j) { Job J; p0_job(F, j, J); run_job(F, J, base); } }
    for (int i = gt; i < 2 * 232 * (DM / 8); i += NGT) { const int e = i / (232 * 128), r = (i / 128) % 232, c = i % 128; *(u32x4*)(WSP(bf16_t, WS_W_EINB) + ((size_t)e * PB_N + 280 + r) * DM + c * 8) = (u32x4){0u, 0u, 0u, 0u}; }
    for (int i = gt; i < 4 * 12 * (DM / 8); i += NGT) { const int l = i / (12 * 128), r = (i / 128) % 12, c = i % 128; *(u32x4*)(WSP(bf16_t, WS_W_RT) + ((size_t)l * 32 + 20 + r) * DM + c * 8) = (u32x4){0u, 0u, 0u, 0u}; }
    { const int* pos = (const int*)F.in[2 + F.z]; float* rope = WSP(float, WS_ROPE);
      for (int i = gt; i < NTOK * 8; i += NGT) { const int tok = i >> 3, k = i & 7;
          const double invrev = k == 0 ? 0.15915494309189535 : k == 1 ? 0.03086376340470123 : k == 2 ? 0.005985185712713705 : k == 3 ? 0.001160663641240061 :
                                k == 4 ? 0.00022507907903927653 : k == 5 ? 4.364795279280289e-05 : k == 6 ? 8.464330808241401e-06 : 1.6414262627950345e-06;
          const double rev = (double)pos[tok] * invrev; const float fr = (float)(rev - __builtin_rint(rev));
          rope[(size_t)tok * 16 + k] = __builtin_amdgcn_cosf(fr); rope[(size_t)tok * 16 + 8 + k] = __builtin_amdgcn_sinf(fr); } }
    for (int m = gw; m < NTOK + NB * MEMLEN; m += NGW) {
        const bool isx = m < NTOK; const int r = isx ? m : m - NTOK;
        const f32x4* xr = (const f32x4*)((isx ? INF(0) : INF(1)) + (size_t)r * DM) + F.lane; f32x4 v[4]; float s = 0.f;
#pragma unroll
        for (int j = 0; j < 4; ++j) { v[j] = xr[64 * j]; s += (v[j].x * v[j].x + v[j].y * v[j].y) + (v[j].z * v[j].z + v[j].w * v[j].w); }
        s = wave_sum(s); const float sc = isx ? 1.0f : 1.0f / sqrtf(s * (1.0f / DM) + EPS);
        u32x2* o8 = (u32x2*)((isx ? WSP(bf16_t, WS_HB) : WSP(bf16_t, WS_MNHAT)) + (size_t)r * DM) + F.lane;
#pragma unroll
        for (int j = 0; j < 4; ++j) { u32x2 w; w.x = cvt_pk_bf16(v[j].x * sc, v[j].y * sc); w.y = cvt_pk_bf16(v[j].z * sc, v[j].w * sc); o8[64 * j] = w; }
        if (isx && F.lane < 16) WSP(float, WS_SSQ)[(size_t)r * 16 + F.lane] = F.lane == 0 ? s : 0.f;
    }
    for (int o = gw; o < 2 * 2 * 128; o += NGW) { const int e = o >> 8, kv = (o >> 7) & 1, c = o & 127; const float* pos = INF(kv ? 20 : 17) + (size_t)e * 2048; const float* w1 = INF(kv ? 21 : 18) + (size_t)e * 2048 * 128;
        float s = 0.f; for (int kk = F.lane; kk < 2048; kk += 64) s += pos[kk] * w1[(size_t)kk * 128 + c];
        s = wave_sum(s); if (F.lane == 0) ((float*)(F.ws + WS_W_CMP2 + 512 * 1024))[o] = s; }
}

struct KvOrder {
    unsigned mn, wk, wv; int G, c;
    __device__ bool next(int i, Unit& u) const { const int L = i * G + c; if (L >= 256) return false; const int l = L >> 6, q = L & 63; u.rows = nullptr; u.x1 = l; u.bd = 0;
        if (q < 32) { u.pm = q >> 2; u.pn = q & 3; u.x0 = 0; u.a = mn + (unsigned)u.pm * 256 * DM * 2; u.b = wk + (unsigned)(l * DM + u.pn * 256) * DM * 2; }
        else { const int q2 = q - 32; u.pm = q2 >> 3; u.pn = q2 & 7; u.x0 = 1; u.a = wv + (unsigned)(l * DM + u.pm * 256) * DM * 2; u.b = mn + (unsigned)u.pn * 256 * DM * 2; }
        return true; }
};

__device__ __forceinline__ f32x16 mfma32(bf16x8 a, bf16x8 b, f32x16 c) { return __builtin_amdgcn_mfma_f32_32x32x16_bf16(a, b, c, 0, 0, 0); }
__device__ __forceinline__ f32x16 zero16() { f32x16 z; for (int i = 0; i < 16; ++i) z[i] = 0.f; return z; }
__device__ __forceinline__ bf16x8 pack8(float a, float b, float c, float d, float e, float f, float g, float h) { u32x4 t; t.x = cvt_pk_bf16(a, b); t.y = cvt_pk_bf16(c, d); t.z = cvt_pk_bf16(e, f); t.w = cvt_pk_bf16(g, h); return __builtin_bit_cast(bf16x8, t); }
__device__ __forceinline__ float xchg32(float v, int hh) { const unsigned u = __float_as_uint(v); const auto r = __builtin_amdgcn_permlane32_swap(u, u, false, false); return __uint_as_float(hh ? r[0] : r[1]); }
__device__ __forceinline__ bf16x8 join8(u32x2 lo, u32x2 hi) { u32x4 t; t.x = lo.x; t.y = lo.y; t.z = hi.x; t.w = hi.y; return __builtin_bit_cast(bf16x8, t); }

constexpr int LRU_XA = 0, LRU_XC = 8576, LRU_WAVE = 17792;
template <bool FINAL>
__device__ __forceinline__ void lru_unit(Frame& F, int e, int b, int tc) {
    const int w = F.wave, lane = F.lane, l31 = lane & 31, hh = lane >> 5;
    const bf16_t* proj = WSP(bf16_t, WS_RA);
    const size_t row0 = (size_t)b * SEQ + (size_t)tc * 64;
    LAS unsigned char* xa = F.lds + w * LRU_WAVE + LRU_XA; LAS unsigned char* xt = F.lds + w * LRU_WAVE + LRU_XC;
    const int lr = lane >> 3, lc = lane & 7;
    u32x4 xr[9], gr[8];
#pragma unroll
    for (int i = 0; i < 9; ++i) { const int rr = i * 8 + lr; const bool ok = (rr < 67) && (tc > 0 || rr >= 3);
        xr[i] = ok ? *(const u32x4*)(proj + (row0 + rr - 3) * PA_N + w * 64 + lc * 8) : (u32x4){0u, 0u, 0u, 0u}; }
    if (FINAL) {
#pragma unroll
        for (int i = 0; i < 8; ++i) gr[i] = *(const u32x4*)(proj + (row0 + i * 8 + lr) * PA_N + 512 + w * 64 + lc * 8);
    }
#pragma unroll
    for (int i = 0; i < 9; ++i) { const int rr = i * 8 + lr; if (rr < 67) *(LAS u32x4*)(xa + rr * 128 + lc * 16) = xr[i]; }
    {
        const int ch = w * 64 + lane; const float* cw = INF(10) + (size_t)e * 4 * 512; const float cb = INF(11)[e * 512 + ch];
        const float w0 = cw[ch], w1 = cw[512 + ch], w2 = cw[1024 + ch], w3 = cw[1536 + ch];
        float x0 = bf2f(*(const LAS bf16_t*)(xa + 0 * 128 + lane * 2)), x1 = bf2f(*(const LAS bf16_t*)(xa + 1 * 128 + lane * 2)), x2 = bf2f(*(const LAS bf16_t*)(xa + 2 * 128 + lane * 2));
#pragma unroll 16
        for (int t = 0; t < 64; ++t) { const float xn = bf2f(*(const LAS bf16_t*)(xa + (t + 3) * 128 + lane * 2)); const float xc = cb + w0 * x0 + w1 * x1 + w2 * x2 + w3 * xn;
            *(LAS bf16_t*)(xt + t * 144 + lane * 2) = f2bf(xc); x0 = x1; x1 = x2; x2 = xn; }
    }
    if (FINAL) {
#pragma unroll
        for (int i = 0; i < 8; ++i) *(LAS u32x4*)(xa + (i * 8 + lr) * 128 + lc * 16) = gr[i];
    }
    LDS_WAIT(); asm volatile("" ::: "memory");
    const bf16_t* wrT = WSP(bf16_t, WS_W_LRU) + (size_t)((e * 2 + 0) * 8 + w) * 4096;
    const bf16_t* wiT = WSP(bf16_t, WS_W_LRU) + (size_t)((e * 2 + 1) * 8 + w) * 4096;
    float* agg = WSP(float, WS_LRUAGG);
#pragma unroll 1
    for (int nb = 0; nb < 2; ++nb) {
        const int cl = nb * 32 + l31, chn = w * 64 + cl;
        bf16x8 br[4], bi[4];
#pragma unroll
        for (int s = 0; s < 4; ++s) { br[s] = *(const bf16x8*)(wrT + cl * 64 + 16 * s + 8 * hh); bi[s] = *(const bf16x8*)(wiT + cl * 64 + 16 * s + 8 * hh); }
        const float brs = INF(13)[e * 512 + chn], bis = INF(15)[e * 512 + chn], sp = log1pf(expf(-INF(16)[e * 512 + chn]));
        float carry = 0.f, atot = 1.f;
        if (FINAL) {
            const f32x2* ap = (const f32x2*)(agg + ((size_t)(b * 64) * 512 + chn) * 2);
            int p = 0;
            for (; p + 16 <= tc; p += 16) { f32x2 ah[16];
#pragma unroll
                for (int k = 0; k < 16; ++k) ah[k] = ap[(size_t)(p + k) * 512];
#pragma unroll
                for (int k = 0; k < 16; ++k) carry = ah[k].x * carry + ah[k].y; }
            for (; p < tc; ++p) { const f32x2 ah = ap[(size_t)p * 512]; carry = ah.x * carry + ah.y; }
        }
#pragma unroll 1
        for (int mb = 0; mb < 2; ++mb) {
            f32x16 ar = zero16(), ai = zero16();
#pragma unroll
            for (int s = 0; s < 4; ++s) { const bf16x8 a = *(const LAS bf16x8*)(xt + (mb * 32 + l31) * 144 + (16 * s + 8 * hh) * 2); ar = mfma32(a, br[s], ar); ai = mfma32(a, bi[s], ai); }
            float av[16], uv[16];
#pragma unroll
            for (int r = 0; r < 16; ++r) { const int t = mb * 32 + (r & 3) + 8 * (r >> 2) + 4 * hh; const float xc = bf2f(*(const LAS bf16_t*)(xt + t * 144 + cl * 2));
                const float rg = sigmoidf_(ar[r] + brs), ig = sigmoidf_(ai[r] + bis); const float la = -8.0f * rg * sp;
                const float a = __expf(la); av[r] = a; uv[r] = __builtin_amdgcn_sqrtf(fmaxf(1.0f - a * a, 0.f)) * (ig * xc); }
            float A[4], H[4], pA[4], pH[4], st[4];
#pragma unroll
            for (int q = 0; q < 4; ++q) { float Aq = 1.f, Hq = 0.f;
#pragma unroll
                for (int i = 0; i < 4; ++i) { Hq = av[4 * q + i] * Hq + uv[4 * q + i]; Aq *= av[4 * q + i]; }
                A[q] = Aq; H[q] = Hq; pA[q] = __shfl_xor(Aq, 32); pH[q] = __shfl_xor(Hq, 32); }
#pragma unroll
            for (int q = 0; q < 4; ++q) { const float A0 = hh ? pA[q] : A[q], H0 = hh ? pH[q] : H[q], A1 = hh ? A[q] : pA[q], H1 = hh ? H[q] : pH[q];
                const float s0 = carry; carry = A0 * carry + H0; const float s1 = carry; carry = A1 * carry + H1; st[q] = hh ? s1 : s0; atot *= A0 * A1; }
            if (FINAL) {
#pragma unroll
                for (int q = 0; q < 4; ++q) { float hc = st[q];
#pragma unroll
                    for (int i = 0; i < 4; ++i) { const int r = 4 * q + i; const int t = mb * 32 + i + 8 * q + 4 * hh; hc = av[r] * hc + uv[r];
                        LAS bf16_t* gp = (LAS bf16_t*)(xa + t * 128 + cl * 2); const float gv = bf2f(*gp); *gp = f2bf(hc * gelu_tanh(gv)); } }
            }
        }
        if (!FINAL && hh == 0) *(f32x2*)(agg + ((size_t)(b * 64 + tc) * 512 + chn) * 2) = (f32x2){atot, carry};
    }
    LDS_WAIT(); asm volatile("" ::: "memory");
    if (FINAL) {
#pragma unroll
        for (int i = 0; i < 8; ++i) *(u32x4*)(WSP(bf16_t, WS_YMIX) + (row0 + i * 8 + lr) * DM + w * 64 + lc * 8) = *(const LAS u32x4*)(xa + (i * 8 + lr) * 128 + lc * 16);
    }
    LDS_WAIT(); asm volatile("" ::: "memory");
}
template <bool FINAL> __device__ __forceinline__ void phase_lru(Frame& F, int e) {
    const int skip = (!FINAL && F.G >= 128) ? 32 : 0;
    if (F.bx < skip) return;
    for (int u = F.bx - skip; u < NB * 64; u += F.G - skip) lru_unit<FINAL>(F, e, u >> 6, u & 63);
}

constexpr int NSA_KROW = 144, NSA_VROW = 144;
constexpr int NSA_KB0 = 0, NSA_VB0 = 9216, NSA_KB1 = 18432, NSA_VB1 = 27648, NSA_SLAB = 36864, NSA_SELM = NSA_SLAB + 4 * 64 * 65 * 4;
constexpr float NSA_SC = 0.125f * 1.4426950408889634f, NSA_THR = 8.0f;
struct NsaTile { u32x4 k, v; };
__device__ __forceinline__ void nsa_load(NsaTile& r, __amdgpu_buffer_rsrc_t rs, unsigned kbase, unsigned kld, unsigned vbase, unsigned vld, int tid) {
    const unsigned rr = (unsigned)tid >> 3, cc = (unsigned)tid & 7u;
    r.k = __builtin_amdgcn_raw_buffer_load_b128(rs, (int)((rr * kld + cc * 8u) * 2u), (int)kbase, 0);
    r.v = __builtin_amdgcn_raw_buffer_load_b128(rs, (int)((rr * vld + cc * 8u) * 2u), (int)vbase, 0);
}
__device__ __forceinline__ void nsa_store(const NsaTile& r, LAS unsigned char* lds, int buf, int tid) {
    const int rr = tid >> 3, cc = tid & 7; LAS unsigned char* kb = lds + (buf ? NSA_KB1 : NSA_KB0), *vb = lds + (buf ? NSA_VB1 : NSA_VB0);
    *(LAS u32x4*)(kb + rr * NSA_KROW + cc * 16) = r.k;
    LAS unsigned char* vrow = vb + rr * NSA_VROW + (cc >> 1) * 32 + (cc & 1) * 8;
    *(LAS u32x2*)(vrow) = (u32x2){r.v.x, r.v.y}; *(LAS u32x2*)(vrow + 16) = (u32x2){r.v.z, r.v.w};
}
__device__ __forceinline__ void nsa_scores(const LAS unsigned char* kb, const bf16x8 (&qf)[4], int l31, int hh, f32x16& s0, f32x16& s1) {
    s0 = zero16(); s1 = zero16();
    bf16x8 a0[4], a1[4];
#pragma unroll
    for (int s = 0; s < 4; ++s) { a0[s] = *(const LAS bf16x8*)(kb + l31 * NSA_KROW + (16 * s + 8 * hh) * 2); a1[s] = *(const LAS bf16x8*)(kb + (l31 + 32) * NSA_KROW + (16 * s + 8 * hh) * 2); }
    __builtin_amdgcn_sched_barrier(0);
#pragma unroll
    for (int s = 0; s < 4; ++s) { s0 = mfma32(a0[s], qf[s], s0); s1 = mfma32(a1[s], qf[s], s1); }
}
#define KJ(kb, r) (32 * (kb) + ((r) & 3) + 8 * ((r) >> 2))
__device__ __forceinline__ void nsa_pv(const LAS unsigned char* vb, const bf16x8 (&pf)[2][2], int l31, int hh, f32x16 (&o)[2]) {
    bf16x8 vf[2][2][2];
#pragma unroll
    for (int dh = 0; dh < 2; ++dh)
#pragma unroll
        for (int kb = 0; kb < 2; ++kb)
#pragma unroll
            for (int st = 0; st < 2; ++st) vf[dh][kb][st] = *(const LAS bf16x8*)(vb + (32 * dh + l31) * NSA_VROW + (32 * kb + 16 * st) * 2 + 16 * hh);
    __builtin_amdgcn_sched_barrier(0);
#pragma unroll
    for (int dh = 0; dh < 2; ++dh)
#pragma unroll
        for (int kb = 0; kb < 2; ++kb)
#pragma unroll
            for (int st = 0; st < 2; ++st) o[dh] = mfma32(vf[dh][kb][st], pf[kb][st], o[dh]);
}
__device__ __forceinline__ void nsa_step(const int MODE, const LAS unsigned char* kb, const LAS unsigned char* vb, const bf16x8 (&qf)[4], bool rowok, int qi, int l31, int hh, float& m, float& l, f32x16 (&o)[2]) {
    f32x16 s[2]; nsa_scores(kb, qf, l31, hh, s[0], s[1]);
    const int q2 = qi - 4 * hh;
    const float nmask = rowok ? 0.f : -3e38f;
    if (MODE != 0) {
        const bool diag = MODE == 1;
#pragma unroll
        for (int b2 = 0; b2 < 2; ++b2)
#pragma unroll
            for (int r = 0; r < 16; ++r) { const bool le = KJ(b2, r) <= q2; s[b2][r] = (le == diag) ? s[b2][r] : -1e30f; }
        asm volatile("" ::: "memory");
    }
    {   float mx = -1e30f;
#pragma unroll
        for (int b2 = 0; b2 < 2; ++b2)
#pragma unroll
            for (int r = 0; r < 16; ++r) mx = fmaxf(mx, s[b2][r]);
        mx = rowok ? mx * NSA_SC : -1e30f;
        mx = fmaxf(mx, xchg32(mx, hh));
        if (!__all(mx <= m + NSA_THR)) { const float mn = fmaxf(m, mx); const float alpha = fast_exp2(m - mn); l *= alpha; m = mn;
#pragma unroll
            for (int dh = 0; dh < 2; ++dh)
#pragma unroll
                for (int r = 0; r < 16; ++r) o[dh][r] *= alpha; }
    }
#pragma unroll
    for (int b2 = 0; b2 < 2; ++b2) {
        bf16x8 vf[2][2];
#pragma unroll
        for (int dh = 0; dh < 2; ++dh)
#pragma unroll
            for (int st = 0; st < 2; ++st) vf[dh][st] = *(const LAS bf16x8*)(vb + (32 * dh + l31) * NSA_VROW + (32 * b2 + 16 * st) * 2 + 16 * hh);
        __builtin_amdgcn_sched_barrier(0);
        const float nm = nmask - m; f32x2 ls2 = {0.f, 0.f};
#pragma unroll
        for (int r = 0; r < 16; r += 2) { const f32x2 sv = {s[b2][r], s[b2][r + 1]}; const f32x2 t = sv * (f32x2){NSA_SC, NSA_SC} + (f32x2){nm, nm};
            const f32x2 p = {fast_exp2(t.x), fast_exp2(t.y)}; s[b2][r] = p.x; s[b2][r + 1] = p.y; ls2 += p; }
        l += ls2.x + ls2.y;
        bf16x8 pf[2];
#pragma unroll
        for (int st = 0; st < 2; ++st) pf[st] = pack8(s[b2][8 * st], s[b2][8 * st + 1], s[b2][8 * st + 2], s[b2][8 * st + 3], s[b2][8 * st + 4], s[b2][8 * st + 5], s[b2][8 * st + 6], s[b2][8 * st + 7]);
        __builtin_amdgcn_sched_barrier(0);
#pragma unroll
        for (int dh = 0; dh < 2; ++dh)
#pragma unroll
            for (int st = 0; st < 2; ++st) o[dh] = mfma32(vf[dh][st], pf[st], o[dh]);
    }
}

__device__ __forceinline__ void nsa_unit(Frame& F, int bg, int c) {
    const int tid = F.tid, w = F.wave, lane = F.lane, l31 = lane & 31, hh = lane >> 5;
    const int b = bg >> 1, g = bg & 1, hd4 = w >> 1, hd = 4 * g + hd4, qi = 32 * (w & 1) + l31;
    const bf16_t* proj = WSP(bf16_t, WS_RA); const bf16_t* vtg = (const bf16_t*)(F.ws + WS_RA + RA_PROJB);
    const size_t tok0 = (size_t)b * SEQ, tok = tok0 + 64 * c + qi;
    LAS unsigned char* lds = F.lds; LAS float* slab = (LAS float*)(lds + NSA_SLAB);
    const __amdgpu_buffer_rsrc_t rs = __builtin_amdgcn_make_buffer_rsrc((void*)(unsigned char*)F.ws, 0, 0xFFFFFFFFu, 0x00020000);
    bf16x8 qn[4], qr0;
#pragma unroll
    for (int s = 0; s < 4; ++s) qn[s] = *(const bf16x8*)(proj + tok * PA_N + 1024 + hd * 64 + 16 * s + 8 * hh);
    { const u32x4 mine = __builtin_bit_cast(u32x4, qn[0]); u32x4 oth; oth.x = __shfl_xor(mine.x, 32); oth.y = __shfl_xor(mine.y, 32); oth.z = __shfl_xor(mine.z, 32); oth.w = __shfl_xor(mine.w, 32);
      const f32x4* rp = (const f32x4*)(WSP(float, WS_ROPE) + tok * 16); const f32x4 c0 = rp[0], c1 = rp[1], s0 = rp[2], s1 = rp[3];
      const float sg = hh ? 1.f : -1.f;
      float xm[8] = {bflo(mine.x), bfhi(mine.x), bflo(mine.y), bfhi(mine.y), bflo(mine.z), bfhi(mine.z), bflo(mine.w), bfhi(mine.w)};
      float xo[8] = {bflo(oth.x), bfhi(oth.x), bflo(oth.y), bfhi(oth.y), bflo(oth.z), bfhi(oth.z), bflo(oth.w), bfhi(oth.w)};
      float cs[8] = {c0.x, c0.y, c0.z, c0.w, c1.x, c1.y, c1.z, c1.w}, sn[8] = {s0.x, s0.y, s0.z, s0.w, s1.x, s1.y, s1.z, s1.w};
      float y[8];
#pragma unroll
      for (int j = 0; j < 8; ++j) y[j] = xm[j] * cs[j] + sg * xo[j] * sn[j];
      qr0 = pack8(y[0], y[1], y[2], y[3], y[4], y[5], y[6], y[7]); }
    float gate[3];
#pragma unroll
    for (int j = 0; j < 3; ++j) gate[j] = sigmoidf_(bf2f(vtg[(size_t)(256 + hd * 3 + j) * NTOK + tok]));
    for (int i = tid; i < 4 * 64 * 65; i += 512) slab[i] = 0.f;
    f32x16 comb[2]; comb[0] = zero16(); comb[1] = zero16();
    NsaTile tl;
    {
        const unsigned kc = (unsigned)WS_KCMP + (unsigned)bg * 256 * 64 * 2, vct = (unsigned)(WS_KCMP + 512 * 1024) + (unsigned)bg * 64 * 256 * 2;
        const int ktmax = c >> 4, nmaxq = (64 * c + qi - 31) >> 4;
        float m = -1e30f, l = 0.f;
        nsa_load(tl, rs, kc, 64, vct, 256, tid); nsa_store(tl, lds, 0, tid); __syncthreads();
        for (int kt = 0; kt <= ktmax; ++kt) {
            if (kt < ktmax) nsa_load(tl, rs, kc + (unsigned)(kt + 1) * 64 * 64 * 2, 64, vct + (unsigned)(kt + 1) * 64 * 2, 256, tid);
            f32x16 s[2]; nsa_scores(lds + ((kt & 1) ? NSA_KB1 : NSA_KB0), qn, l31, hh, s[0], s[1]);
            const int hi = nmaxq - 64 * kt - 4 * hh; float mx = -1e30f;
#pragma unroll
            for (int b2 = 0; b2 < 2; ++b2)
#pragma unroll
                for (int r = 0; r < 16; ++r) { const float x = (KJ(b2, r) <= hi) ? s[b2][r] * NSA_SC : -1e30f; s[b2][r] = x; mx = fmaxf(mx, x); }
            mx = fmaxf(mx, __shfl_xor(mx, 32)); const float mn = fmaxf(m, mx); float ls = 0.f;
#pragma unroll
            for (int b2 = 0; b2 < 2; ++b2)
#pragma unroll
                for (int r = 0; r < 16; ++r) ls += (s[b2][r] > -1e29f) ? fast_exp2(s[b2][r] - mn) : 0.f;
            ls += __shfl_xor(ls, 32); l = l * fast_exp2(m - mn) + ls; m = mn;
            if (kt < ktmax) nsa_store(tl, lds, (kt + 1) & 1, tid);
            __syncthreads();
        }
        const float inv_l = l > 0.f ? 1.0f / l : 0.f;
        f32x16 o[2]; o[0] = zero16(); o[1] = zero16();
        nsa_load(tl, rs, kc, 64, vct, 256, tid); nsa_store(tl, lds, 0, tid); __syncthreads();
        float icarry = 0.f;
        for (int kt = 0; kt <= ktmax; ++kt) {
            if (kt < ktmax) nsa_load(tl, rs, kc + (unsigned)(kt + 1) * 64 * 64 * 2, 64, vct + (unsigned)(kt + 1) * 64 * 2, 256, tid);
            f32x16 s[2]; nsa_scores(lds + ((kt & 1) ? NSA_KB1 : NSA_KB0), qn, l31, hh, s[0], s[1]);
            const int hi = nmaxq - 64 * kt - 4 * hh;
#pragma unroll
            for (int b2 = 0; b2 < 2; ++b2)
#pragma unroll
                for (int r = 0; r < 16; ++r) s[b2][r] = (KJ(b2, r) <= hi) ? fast_exp2(s[b2][r] * NSA_SC - m) * inv_l : 0.f;
            { float own[8], pl[8];
#pragma unroll
              for (int b2 = 0; b2 < 2; ++b2)
#pragma unroll
                  for (int q4 = 0; q4 < 4; ++q4) { own[4 * b2 + q4] = (s[b2][4 * q4] + s[b2][4 * q4 + 1]) + (s[b2][4 * q4 + 2] + s[b2][4 * q4 + 3]); pl[4 * b2 + q4] = xchg32(s[b2][4 * q4 + 3], hh); }
              LAS float* sp = slab + (hd4 * 64 + qi) * 65 + 16 * kt + hh;
#pragma unroll
              for (int i = 0; i < 8; ++i) sp[2 * i] = own[i] + (hh ? pl[i] : (i ? pl[i - 1] : icarry));
              icarry = pl[7];
              if (kt == ktmax && hh == 0 && 16 * (kt + 1) < 64) sp[16] = icarry; }
            bf16x8 pf[2][2];
#pragma unroll
            for (int b2 = 0; b2 < 2; ++b2)
#pragma unroll
                for (int st = 0; st < 2; ++st) pf[b2][st] = pack8(s[b2][8 * st], s[b2][8 * st + 1], s[b2][8 * st + 2], s[b2][8 * st + 3], s[b2][8 * st + 4], s[b2][8 * st + 5], s[b2][8 * st + 6], s[b2][8 * st + 7]);
            nsa_pv(lds + ((kt & 1) ? NSA_VB1 : NSA_VB0), pf, l31, hh, o);
            if (kt < ktmax) nsa_store(tl, lds, (kt + 1) & 1, tid);
            __syncthreads();
        }
#pragma unroll
        for (int dh = 0; dh < 2; ++dh)
#pragma unroll
            for (int r = 0; r < 16; ++r) comb[dh][r] = gate[0] * o[dh][r];
    }
    {
        LAS unsigned long long* selm = (LAS unsigned long long*)(lds + NSA_SELM);
        if (c < 16) {
            if (lane < 8) selm[8 * w + lane] = (2ull << c) - 1ull;
        } else {
            const bool causal = lane <= c, forced = (lane == 0) || (lane == c) || (lane == c - 1);
#pragma unroll 1
            for (int g4 = 0; g4 < 2; ++g4) {
                unsigned key[4], T[4];
#pragma unroll
                for (int j = 0; j < 4; ++j) { const int q = 8 * w + 4 * g4 + j;
                    const float imp = ((slab[(0 * 64 + q) * 65 + lane] + slab[(1 * 64 + q) * 65 + lane]) + slab[(2 * 64 + q) * 65 + lane]) + slab[(3 * 64 + q) * 65 + lane];
                    key[j] = causal ? (forced ? 0xFFFFFFFFu : __float_as_uint(fmaxf(imp, 0.f))) : 0u; T[j] = 0u; }
#pragma unroll
                for (int bit = 31; bit >= 0; --bit) {
#pragma unroll
                    for (int j = 0; j < 4; ++j) { const unsigned cand = T[j] | (1u << bit); const unsigned long long bm = __builtin_amdgcn_ballot_w64(key[j] >= cand); const int cnt = __builtin_popcount((unsigned)bm) + __builtin_popcount((unsigned)(bm >> 32)); T[j] = cnt >= 16 ? cand : T[j]; } }
#pragma unroll
                for (int j = 0; j < 4; ++j) { const int q = 8 * w + 4 * g4 + j;
                    const unsigned long long gt = __ballot(key[j] > T[j]); const bool iseq = key[j] == T[j]; const unsigned long long eq = __ballot(iseq); const int need = 16 - __popcll(gt);
                    const int below = (int)__builtin_amdgcn_mbcnt_hi((unsigned)(eq >> 32), __builtin_amdgcn_mbcnt_lo((unsigned)eq, 0u));
                    const unsigned long long pick = __ballot(iseq && below < need);
                    if (lane == 0) selm[q] = gt | pick; } }
        }
        __syncthreads();
    }
    const unsigned long long mysel = ((const LAS unsigned long long*)(lds + NSA_SELM))[qi];
    qn[0] = qr0;
#pragma unroll 1
    for (int br = 0; br < 2; ++br) {
        const unsigned kbase = (unsigned)WS_RA + (unsigned)((unsigned)tok0 * PA_N + (br ? 1920 : 1792) + 64 * g) * 2u, vbase = (unsigned)(WS_RA + RA_PROJB) + (unsigned)(((br ? 128 : 0) + 64 * g) * NTOK + (unsigned)tok0) * 2u;
        const int ntile = br ? ((c < 8 ? c : 8) + 1) : (c + 1);
        float m = -1e30f, l = 0.f; f32x16 o[2]; o[0] = zero16(); o[1] = zero16();
        { const int kb0 = br ? c : 0; nsa_load(tl, rs, kbase + (unsigned)kb0 * 64 * PA_N * 2, PA_N, vbase + (unsigned)kb0 * 64 * 2, NTOK, tid); nsa_store(tl, lds, 0, tid);
          if (ntile > 1) { const int kn = br ? (c - 1) : 1; nsa_load(tl, rs, kbase + (unsigned)kn * 64 * PA_N * 2, PA_N, vbase + (unsigned)kn * 64 * 2, NTOK, tid); }
          __syncthreads(); }
        for (int it = 0; it < ntile; ++it) {
            const int kb = br ? (c - it) : it;
            if (it + 1 < ntile) nsa_store(tl, lds, (it + 1) & 1, tid);
            if (it + 2 < ntile) { const int kn = br ? (c - it - 2) : (it + 2); nsa_load(tl, rs, kbase + (unsigned)kn * 64 * PA_N * 2, PA_N, vbase + (unsigned)kn * 64 * 2, NTOK, tid); }
            const bool rowok = br ? true : (((mysel >> kb) & 1ull) != 0ull);
            const LAS unsigned char* kbuf = lds + ((it & 1) ? NSA_KB1 : NSA_KB0); const LAS unsigned char* vbuf = lds + ((it & 1) ? NSA_VB1 : NSA_VB0);
            nsa_step(kb == c ? 1 : (br && kb == c - 8) ? 2 : 0, kbuf, vbuf, qn, rowok, qi, l31, hh, m, l, o);
            __syncthreads();
        }
        l += xchg32(l, hh);
        const float gl = gate[1 + br] * (l > 0.f ? 1.0f / l : 0.f);
#pragma unroll
        for (int dh = 0; dh < 2; ++dh)
#pragma unroll
            for (int r = 0; r < 16; ++r) comb[dh][r] += gl * o[dh][r];
    }
    bf16_t* yo = WSP(bf16_t, WS_YMIX) + tok * DM + 512 + hd * 64;
#pragma unroll
    for (int dh = 0; dh < 2; ++dh)
#pragma unroll
        for (int q4 = 0; q4 < 4; ++q4) { u32x2 pk; pk.x = cvt_pk_bf16(comb[dh][4 * q4], comb[dh][4 * q4 + 1]); pk.y = cvt_pk_bf16(comb[dh][4 * q4 + 2], comb[dh][4 * q4 + 3]);
            *(u32x2*)(yo + 32 * dh + 8 * q4 + 4 * hh) = pk; }
    __syncthreads();
}
__device__ __forceinline__ void phase_nsa(Frame& F) {
    for (int u = F.bx; u < 1024; u += F.G) { const int round = u >> 8, bl = u & 255, bg = (bl & 7) * 2 + (bl >> 7), jj = (bl >> 3) & 15;
        const int c = round == 0 ? jj : round == 1 ? 31 - jj : round == 2 ? 32 + jj : 63 - jj; nsa_unit(F, bg, c); }
}

struct CmpOrder { unsigned projA, w1; int G, c;
    __device__ bool next(int i, Unit& u) const { const int L = i * G + c; if (L >= 32) return false; u.x0 = L >> 4; u.pm = L & 15; u.pn = 0; u.x1 = 0; u.rows = nullptr; u.bd = 0;
        const int b = u.pm >> 1, g = u.pm & 1; u.a = projA + (unsigned)(b * SEQ * PA_N + (u.x0 ? 1664 : 1536) + 64 * g) * 2; u.b = w1 + (unsigned)u.x0 * 256 * 1024 * 2; return true; }
};
struct EpiCompress {
    static constexpr bool PERM = false, AFTER_DRAIN = true;
    const bf16_t* w2t;
    const float* pb;
    bf16_t* kcmp; bf16_t* vct;
    __device__ __forceinline__ void operator()(const AccT&, const Unit&, int, int, int, int) const {}
    __device__ __forceinline__ void fused(AccT& acc, const Unit& u, int wr, int wc, int fr, int fq, LAS unsigned char* lds, int wid, int lane) const {
        LAS float* P2 = (LAS float*)lds;
        asm volatile("" ::: "memory"); __syncthreads();
        LAS unsigned char* Hb = lds;
#pragma unroll
        for (int ai = 0; ai < 2; ++ai)
#pragma unroll
            for (int m = 0; m < 4; ++m) { const int r = ai * 128 + wr * 64 + m * 16 + fr;
#pragma unroll
                for (int n = 0; n < 2; ++n) *(LAS f32x4*)(P2 + r * 128 + wc * 32 + n * 16 + 4 * fq) = acc[ai][1][m][n]; }
        __syncthreads();
        const float* pbk = pb + u.x0 * 128;
#pragma unroll
        for (int ai = 0; ai < 2; ++ai)
#pragma unroll
            for (int m = 0; m < 4; ++m) { const int r = ai * 128 + wr * 64 + m * 16 + fr;
#pragma unroll
                for (int n = 0; n < 2; ++n) { const int c0 = wc * 32 + n * 16 + 4 * fq; const f32x4 sh = (r < 255) ? *(const LAS f32x4*)(P2 + (r + 1) * 128 + c0) : (f32x4){0.f, 0.f, 0.f, 0.f}; const f32x4 bv = *(const f32x4*)(pbk + c0);
                    f32x4 v = acc[ai][0][m][n] + sh + bv;
#pragma unroll
                    for (int j = 0; j < 4; ++j) v[j] = gelu_tanh(v[j]);
                    acc[ai][0][m][n] = v; } }
        __syncthreads();
#pragma unroll
        for (int ai = 0; ai < 2; ++ai)
#pragma unroll
            for (int m = 0; m < 4; ++m) { const int r = ai * 128 + wr * 64 + m * 16 + fr;
#pragma unroll
                for (int n = 0; n < 2; ++n) { const f32x4 v = acc[ai][0][m][n]; u32x2 pk; pk.x = cvt_pk_bf16(v[0], v[1]); pk.y = cvt_pk_bf16(v[2], v[3]);
                    *(LAS u32x2*)(Hb + r * 272 + (wc * 32 + n * 16 + 4 * fq) * 2) = pk; } }
        __syncthreads();
        const int l31 = lane & 31, hh = lane >> 5; const bf16_t* w2 = w2t + (size_t)u.x0 * 64 * 128; const int bg = u.pm;
        bf16x8 hf[8];
#pragma unroll
        for (int s = 0; s < 8; ++s) hf[s] = *(const LAS bf16x8*)(Hb + (32 * wid + l31) * 272 + (16 * s + 8 * hh) * 2);
#pragma unroll
        for (int db = 0; db < 2; ++db) { f32x16 o = zero16();
            if (u.x0 == 0) {
#pragma unroll
                for (int s = 0; s < 8; ++s) { const bf16x8 wf = *(const bf16x8*)(w2 + (32 * db + l31) * 128 + 16 * s + 8 * hh); o = mfma32(wf, hf[s], o); }
                const int i = 32 * wid + l31;
#pragma unroll
                for (int q4 = 0; q4 < 4; ++q4) { u32x2 pk; pk.x = cvt_pk_bf16(o[4 * q4], o[4 * q4 + 1]); pk.y = cvt_pk_bf16(o[4 * q4 + 2], o[4 * q4 + 3]); if (i == 255) { pk.x = 0u; pk.y = 0u; }
                    *(u32x2*)(kcmp + ((size_t)bg * 256 + i) * 64 + 32 * db + 8 * q4 + 4 * hh) = pk; }
            } else {
#pragma unroll
                for (int s = 0; s < 8; ++s) { const bf16x8 wf = *(const bf16x8*)(w2 + (32 * db + l31) * 128 + 16 * s + 8 * hh); o = mfma32(hf[s], wf, o); }
                const int d = 32 * db + l31;
#pragma unroll
                for (int q4 = 0; q4 < 4; ++q4) { const int i0 = 32 * wid + 8 * q4 + 4 * hh; float v3 = o[4 * q4 + 3]; if (i0 + 3 == 255) v3 = 0.f;
                    u32x2 pk; pk.x = cvt_pk_bf16(o[4 * q4], o[4 * q4 + 1]); pk.y = cvt_pk_bf16(o[4 * q4 + 2], v3);
                    *(u32x2*)(vct + ((size_t)bg * 64 + d) * 256 + i0) = pk; }
            } }
        __syncthreads();
    }
};

__device__ __forceinline__ void phase_oddconv(Frame& F, int o) {
    const bf16_t* Bg = WSP(bf16_t, WS_RA); const bf16_t* CV = (const bf16_t*)(F.ws + WS_RA + 64 * MiB); bf16_t* Z = WSP(bf16_t, WS_YMIX);
    const float* cw = INF(24) + (size_t)o * 3 * DM;
    const int cg = F.tid & 127, sub = F.tid >> 7;
    float w0[8], w1[8], w2[8];
#pragma unroll
    for (int j = 0; j < 8; ++j) { w0[j] = cw[cg * 8 + j]; w1[j] = cw[DM + cg * 8 + j]; w2[j] = cw[2 * DM + cg * 8 + j]; }
    for (int u = F.bx; u < NTOK / 64; u += F.G) {
        const int t0 = (u * 64 + sub * 16); const int tin = t0 & (SEQ - 1);
        u32x4 p2 = {0u, 0u, 0u, 0u}, p1 = p2;
        if (tin >= 2) { p2 = *(const u32x4*)(CV + (size_t)(t0 - 2) * DM + cg * 8); p1 = *(const u32x4*)(CV + (size_t)(t0 - 1) * DM + cg * 8); }
#pragma unroll 4
        for (int t = 0; t < 16; ++t) { const size_t off = (size_t)(t0 + t) * DM + cg * 8; const u32x4 c0 = *(const u32x4*)(CV + off), bb = *(const u32x4*)(Bg + off);
            float o8[8]; const unsigned a2[4] = {p2.x, p2.y, p2.z, p2.w}, a1[4] = {p1.x, p1.y, p1.z, p1.w}, a0[4] = {c0.x, c0.y, c0.z, c0.w}, ab[4] = {bb.x, bb.y, bb.z, bb.w};
#pragma unroll
            for (int j = 0; j < 4; ++j) { o8[2 * j] = bflo(ab[j]) * (w0[2 * j] * bflo(a2[j]) + w1[2 * j] * bflo(a1[j]) + w2[2 * j] * bflo(a0[j]));
                o8[2 * j + 1] = bfhi(ab[j]) * (w0[2 * j + 1] * bfhi(a2[j]) + w1[2 * j + 1] * bfhi(a1[j]) + w2[2 * j + 1] * bfhi(a0[j])); }
            u32x4 pk; pk.x = cvt_pk_bf16(o8[0], o8[1]); pk.y = cvt_pk_bf16(o8[2], o8[3]); pk.z = cvt_pk_bf16(o8[4], o8[5]); pk.w = cvt_pk_bf16(o8[6], o8[7]);
            *(u32x4*)(Z + off) = pk; p2 = p1; p1 = c0; }
    }
}

constexpr int XA_KROW = 144, XA_VROW = 528, XA_KBUF = 36864, XA_VBUF = 16896, XA_KOFF = 0, XA_VOFF = 2 * XA_KBUF;
__device__ __forceinline__ void xattn_unit(Frame& F, int layer, int b, int head, int qb) {
    const int tid = F.tid, w = F.wave, lane = F.lane, l31 = lane & 31, hh = lane >> 5;
    LAS unsigned char* lds = F.lds;
    const bf16_t* Q = WSP(bf16_t, WS_RA);
    const bf16_t* Kx = WSP(bf16_t, WS_XK) + ((size_t)layer * 2048 + b * 256) * DM + head * 256;
    const bf16_t* Vt = WSP(bf16_t, WS_XVT) + ((size_t)layer * DM + head * 256) * 2048 + b * 256;
    const size_t tok = (size_t)b * SEQ + qb * 256 + w * 32 + l31;
    const bf16_t* qrow = Q + tok * DM + head * 256;
    const int kkey = tid >> 1, khalf = tid & 1, vd = tid >> 4, vcc = tid & 15;
    f32x16 s[8];
#pragma unroll
    for (int kb = 0; kb < 8; ++kb) s[kb] = zero16();
    u32x4 kr[4];
    { const u32x4* src = (const u32x4*)(Kx + (size_t)kkey * DM + khalf * 32); kr[0] = src[0]; kr[1] = src[1]; kr[2] = src[2]; kr[3] = src[3]; }
    { LAS u32x4* dst = (LAS u32x4*)(lds + XA_KOFF + kkey * XA_KROW + khalf * 64); dst[0] = kr[0]; dst[1] = kr[1]; dst[2] = kr[2]; dst[3] = kr[3]; }
    u32x4 vr[2];
#pragma unroll 1
    for (int ch = 0; ch < 4; ++ch) {
        bf16x8 qf[4];
#pragma unroll
        for (int s4 = 0; s4 < 4; ++s4) qf[s4] = *(const bf16x8*)(qrow + ch * 64 + 16 * s4 + 8 * hh);
        if (ch < 3) { const u32x4* src = (const u32x4*)(Kx + (size_t)kkey * DM + (ch + 1) * 64 + khalf * 32); kr[0] = src[0]; kr[1] = src[1]; kr[2] = src[2]; kr[3] = src[3]; }
        else { const u32x4* src = (const u32x4*)(Vt + (size_t)vd * 2048 + vcc * 16); vr[0] = src[0]; vr[1] = src[1]; }
        __syncthreads();
        const LAS unsigned char* kbuf = lds + XA_KOFF + (ch & 1) * XA_KBUF;
#pragma unroll
        for (int s4 = 0; s4 < 4; ++s4) {
#pragma unroll
            for (int k2 = 0; k2 < 2; ++k2) { bf16x8 kf[4];
#pragma unroll
                for (int kb = 0; kb < 4; ++kb) kf[kb] = *(const LAS bf16x8*)(kbuf + (32 * (4 * k2 + kb) + l31) * XA_KROW + (16 * s4 + 8 * hh) * 2);
                __builtin_amdgcn_sched_barrier(0);
#pragma unroll
                for (int kb = 0; kb < 4; ++kb) s[4 * k2 + kb] = mfma32(kf[kb], qf[s4], s[4 * k2 + kb]); } }
        if (ch < 3) { LAS u32x4* dst = (LAS u32x4*)(lds + XA_KOFF + ((ch + 1) & 1) * XA_KBUF + kkey * XA_KROW + khalf * 64); dst[0] = kr[0]; dst[1] = kr[1]; dst[2] = kr[2]; dst[3] = kr[3]; }
    }
#define XA_VSTORE(buf) do { LAS u32x2* dst = (LAS u32x2*)(lds + XA_VOFF + (buf) * XA_VBUF + vd * XA_VROW + vcc * 32); \
        dst[0] = (u32x2){vr[0].x, vr[0].y}; dst[2] = (u32x2){vr[0].z, vr[0].w}; dst[1] = (u32x2){vr[1].x, vr[1].y}; dst[3] = (u32x2){vr[1].z, vr[1].w}; } while (0)
    XA_VSTORE(0);
    constexpr float SC = 0.0625f * 1.4426950408889634f;
    float mx = -1e30f;
#pragma unroll
    for (int kb = 0; kb < 8; ++kb)
#pragma unroll
        for (int r = 0; r < 16; ++r) mx = fmaxf(mx, s[kb][r]);
    mx = fmaxf(mx, __shfl_xor(mx, 32)); const float mb = mx * SC; float ls = 0.f;
    bf16x8 pf[8][2];
#pragma unroll
    for (int kb = 0; kb < 8; ++kb) { float p[16];
#pragma unroll
        for (int r = 0; r < 16; ++r) { p[r] = fast_exp2(__builtin_fmaf(s[kb][r], SC, -mb)); ls += p[r]; }
        pf[kb][0] = pack8(p[0], p[1], p[2], p[3], p[4], p[5], p[6], p[7]); pf[kb][1] = pack8(p[8], p[9], p[10], p[11], p[12], p[13], p[14], p[15]); }
    ls += __shfl_xor(ls, 32); const float inv = __builtin_amdgcn_rcpf(ls);
#pragma unroll 1
    for (int db = 0; db < 8; ++db) {
        if (db < 7) { const u32x4* src = (const u32x4*)(Vt + (size_t)(32 * (db + 1) + vd) * 2048 + vcc * 16); vr[0] = src[0]; vr[1] = src[1]; }
        __syncthreads();
        const LAS unsigned char* vbuf = lds + XA_VOFF + (db & 1) * XA_VBUF;
        f32x16 o = zero16();
#pragma unroll
        for (int k4 = 0; k4 < 4; ++k4) { bf16x8 vf[4];
#pragma unroll
            for (int i = 0; i < 4; ++i) vf[i] = *(const LAS bf16x8*)(vbuf + l31 * XA_VROW + (32 * (2 * k4 + (i >> 1)) + 16 * (i & 1)) * 2 + 16 * hh);
            __builtin_amdgcn_sched_barrier(0);
#pragma unroll
            for (int i = 0; i < 4; ++i) o = mfma32(vf[i], pf[2 * k4 + (i >> 1)][i & 1], o); }
        bf16_t* orow = WSP(bf16_t, WS_YMIX) + tok * DM + head * 256 + 32 * db;
#pragma unroll
        for (int q4 = 0; q4 < 4; ++q4) { u32x2 pk; pk.x = cvt_pk_bf16(o[4 * q4] * inv, o[4 * q4 + 1] * inv); pk.y = cvt_pk_bf16(o[4 * q4 + 2] * inv, o[4 * q4 + 3] * inv);
            *(u32x2*)(orow + 8 * q4 + 4 * hh) = pk; }
        if (db < 7) XA_VSTORE((db + 1) & 1);
    }
    __syncthreads();
#undef XA_VSTORE
}
__device__ __forceinline__ void phase_xattn(Frame& F, int layer) {
    for (int u = F.bx; u < NB * 4 * 16; u += F.G) xattn_unit(F, layer, u >> 6, (u >> 4) & 3, u & 15);
}

__device__ __forceinline__ void phase_router(Frame& F, int layer) {
    const int tid = F.tid, w = F.wave, lane = F.lane, l31 = lane & 31, hh = lane >> 5;
    LAS int* lcnt = (LAS int*)(F.lds + 8 * 16640);
    float* route_w = (float*)(F.ws + WS_ROUTE + 512 * 1024); int* perm = WSP(int, WS_PERM);
    unsigned* gcnt = WSP(unsigned, WS_CTL) + CW_CNT + layer * 32 * 16;
    for (int base = F.bx * 128; base < NTOK; base += F.G * 128) {
        if (tid < 64) lcnt[tid] = 0;
        __syncthreads();
        int e0 = 0, rk0 = 0; const int tok = base + w * 32 + l31;
        if (w < 4) {
            const bf16_t* wr = WSP(bf16_t, WS_W_RT) + (size_t)layer * 32 * DM + (size_t)l31 * DM; const bf16_t* xr = WSP(bf16_t, WS_HB) + (size_t)tok * DM;
            f32x16 acc = zero16();
#pragma unroll 8
            for (int s = 0; s < 64; ++s) { const bf16x8 a = *(const bf16x8*)(wr + 16 * s + 8 * hh), bq = *(const bf16x8*)(xr + 16 * s + 8 * hh); acc = mfma32(a, bq, acc); }
            float mine[12], oth[12];
#pragma unroll
            for (int r = 0; r < 12; ++r) { mine[r] = acc[r]; oth[r] = __shfl_xor(acc[r], 32); }
            const float rs = row_rstd(WSP(float, WS_SSQ), tok);
            if (hh == 0) ((float*)(F.ws + WS_ROUTE + 768 * 1024))[tok] = rs;
            float lg[20];
#pragma unroll
            for (int n = 0; n < 20; ++n) { const int hn = (n >> 2) & 1, r = (n & 3) + 4 * (n >> 3); lg[n] = (hh == hn) ? mine[r] : oth[r]; }
            const float* bgp = INF(31) + layer * 4; const float* bep = INF(33) + layer * 16;
            float gl[4]; int gi = 0; float gm = -1e30f;
#pragma unroll
            for (int j = 0; j < 4; ++j) { gl[j] = lg[j] * rs + bgp[j]; if (gl[j] > gm) { gm = gl[j]; gi = j; } }
            float gs = 0.f;
#pragma unroll
            for (int j = 0; j < 4; ++j) gs += __expf(gl[j] - gm);
            const float gtop = 1.0f / gs;
            float el[4];
#pragma unroll
            for (int j = 0; j < 4; ++j) { float v = 0.f;
#pragma unroll
                for (int g2 = 0; g2 < 4; ++g2) v = (gi == g2) ? (lg[4 + 4 * g2 + j] * rs + bep[4 * g2 + j]) : v;
                el[j] = v; }
            int i0 = 0; float v0 = el[0];
#pragma unroll
            for (int j = 1; j < 4; ++j) if (el[j] > v0) { v0 = el[j]; i0 = j; }
            int i1 = -1; float v1 = -1e30f;
#pragma unroll
            for (int j = 0; j < 4; ++j) if (j != i0 && el[j] > v1) { v1 = el[j]; i1 = j; }
            const float ex = __expf(v1 - v0), w0 = gtop / (1.0f + ex), w1 = gtop * ex / (1.0f + ex);
            { const int a = i0 < i1 ? i0 : i1, b2 = i0 < i1 ? i1 : i0; const int p6 = a == 0 ? b2 - 1 : a == 1 ? b2 + 1 : 5; e0 = gi * 6 + p6;
              if (hh == 0) { route_w[(size_t)tok * 2] = i0 < i1 ? w0 : w1; route_w[(size_t)tok * 2 + 1] = i0 < i1 ? w1 : w0; rk0 = atomicAdd((int*)&lcnt[e0], 1); } }
        }
        __syncthreads();
        if (tid < 32) { const int n = lcnt[tid]; lcnt[32 + tid] = n ? (int)atomicAdd(&gcnt[tid * 16], (unsigned)n) : 0; }
        __syncthreads();
        if (w < 4 && hh == 0) perm[(size_t)e0 * NTOK + lcnt[32 + e0] + rk0] = tok;
        __syncthreads();
    }
    moe_convert_drain(F, layer);
}

constexpr int MOE_NB = 24;
constexpr int MOE_TAB = LDS_MISC + 64;
constexpr int MOE_TKM = LDS_MISC + 512;
__device__ __forceinline__ void moe_table(Frame& F, int layer) {
    LAS int* tab = (LAS int*)(F.lds + MOE_TAB);
    if (F.tid < 64) { const unsigned* gcnt = WSP(unsigned, WS_CTL) + CW_CNT + layer * 32 * 16; const int k = F.tid;
        const int n = k < MOE_NB ? (int)__hip_atomic_load(gcnt + k * 16, __ATOMIC_RELAXED, __HIP_MEMORY_SCOPE_AGENT) : 0;
        const int tiles = (n + 255) >> 8; int incl = tiles;
#pragma unroll
        for (int o = 1; o < 32; o <<= 1) { const int t = __shfl_up(incl, o); if (k >= o) incl += t; }
        if (k < MOE_NB) { tab[k] = incl - tiles; tab[33 + k] = n; }
        if (k == MOE_NB - 1) tab[MOE_NB] = incl; }
    __syncthreads();
    { LAS unsigned char* tk = (LAS unsigned char*)(F.lds + MOE_TKM); const int nt = tab[MOE_NB];
      for (int t = F.tid; t < nt; t += 512) { int k = 0;
#pragma unroll 1
          for (int qq = 1; qq < MOE_NB; ++qq) if (tab[qq] <= t) k = qq;
          tk[t] = (unsigned char)k; } }
    __syncthreads();
}
struct MoeOrder {
    const LAS int* tab; const int* perm; unsigned A, Bw; int G, c; bool down;
    __device__ bool next(int i, Unit& u) const {
        const int L = i * G + c, nt = tab[MOE_NB], q = L >> 3; int tile, sub;
        if (down) { sub = q & 3; tile = (q >> 2) * 8 + (L & 7); } else { sub = q & 7; tile = (q >> 3) * 8 + (L & 7); }
        if (tile >= nt) return false;
        const int k = ((const LAS unsigned char*)((const LAS unsigned char*)tab - MOE_TAB + MOE_TKM))[tile];
        const int rt = tile - tab[k], n = tab[33 + k], gi = k / 6, p6 = k - gi * 6;
        const int ea = gi * 4 + (p6 < 3 ? 0 : p6 < 5 ? 1 : 2), eb = gi * 4 + (p6 < 3 ? p6 + 1 : p6 < 5 ? p6 - 1 : 3);
        u.x0 = n - rt * 256 < 256 ? n - rt * 256 : 256; u.x1 = tile * 256; u.rows = perm + (size_t)k * NTOK + rt * 256; u.bd = 0;
        if (down) { u.pn = sub; u.pm = 0; u.a = A + (unsigned)tile * 256 * 1024 * 2; u.b = Bw + (unsigned)(ea * DM + sub * 256) * 512 * 2; u.bd = (eb - ea) * DM * 512 * 2 - 8 * 128; }
        else { const int sl = sub >> 2; u.pn = sub & 3; u.pm = sl; u.a = A; u.b = Bw + (unsigned)((sl ? eb : ea) * DM + u.pn * 256) * DM * 2; }
        return true; }
};

__device__ __forceinline__ void phase_final(Frame& F) {
    const int gw = F.bx * 8 + F.wave, NGW = F.G * 8; const f32x4* gp = (const f32x4*)INF(7) + F.lane;
    f32x4 gv[4];
#pragma unroll
    for (int j = 0; j < 4; ++j) gv[j] = gp[64 * j];
    for (int m = gw; m < NTOK; m += NGW) { const u32x2* hr = (const u32x2*)(WSP(bf16_t, WS_HB) + (size_t)m * DM) + F.lane; f32x4* xr = (f32x4*)(F.out + (size_t)m * DM) + F.lane; f32x4 v[4]; float s = 0.f;
#pragma unroll
        for (int j = 0; j < 4; ++j) { const u32x2 w = hr[64 * j]; v[j] = (f32x4){bflo(w.x), bfhi(w.x), bflo(w.y), bfhi(w.y)}; s += (v[j].x * v[j].x + v[j].y * v[j].y) + (v[j].z * v[j].z + v[j].w * v[j].w); }
        const float rs = 1.0f / sqrtf(wave_sum(s) * (1.0f / DM) + EPS);
#pragma unroll
        for (int j = 0; j < 4; ++j) xr[64 * j] = v[j] * rs * gv[j]; }
}

constexpr int NPHASE = 2 + 11 * DEPTH + 1;
template <unsigned PHMASK> __global__ void __launch_bounds__(512, 2) hybrid_fwd(Args args) {
    extern __shared__ __attribute__((aligned(16))) unsigned char lds_raw[];
    Frame F; F.lds = (LAS unsigned char*)lds_raw; F.tid = threadIdx.x; F.lane = F.tid & 63; F.wave = __builtin_amdgcn_readfirstlane(F.tid >> 6); F.G = gridDim.x; F.bx = blockIdx.x;
    F.ws = (GAS unsigned char*)args.ws; F.out = (GAS float*)args.out; F.in = args.in; F.z = 0;
    const int lo = (PHMASK == 0xFFFFu) ? 0 : args.ph_lo, hi = (PHMASK == 0xFFFFu) ? NPHASE : args.ph_hi;
    for (int u = F.tid; u < (LDS_BYTES - LDS_MISC) / 4; u += 512) ((LAS unsigned*)(F.lds + LDS_MISC))[u] = 0u;
    __syncthreads();
    if (hi - lo > 1) (void)xcd_barrier_post((unsigned*)(F.ws + WS_CTL) + CW_BAR, (volatile LAS unsigned*)(F.lds + LDS_MISC), F.tid);
#define PM(b) ((PHMASK >> (b)) & 1)
#define IN(p) (lo <= (p) && (p) < hi)
#define GRIDBAR() do { XcdBarrier b2_; b2_.bar = (unsigned*)(F.ws + WS_CTL) + CW_BAR; b2_.x = xb_xcc_id(); b2_.st = (volatile LAS unsigned*)(F.lds + LDS_MISC); asm volatile("" : "+s"(b2_.bar)); xcd_barrier(b2_, F.tid); } while (0)
#define SEAM(p) do { if ((p) + 1 < hi) GRIDBAR(); } while (0)
#define LAUNDER() do { asm volatile("" : "+v"(F.tid)); F.lane = F.tid & 63; asm volatile("" : "+s"(F.z)); asm volatile("" : "+s"(F.ws)); asm volatile("" : "+s"(F.bx)); asm volatile("" : "+s"(F.G)); } while (0)
    const pg8::Gemm gstd{DM, DM, 128, 128, DM, 0, 1 << 30};
#define ssq WSP(float, WS_SSQ)
#define hb WSP(bf16_t, WS_HB)

    if (PM(0) && IN(0)) { LAUNDER(); phase_prologue(F); SEAM(0); }
    if (PM(1) && IN(1)) { LAUNDER();
        KvOrder S{(unsigned)WS_MNHAT, (unsigned)WS_W_XK, (unsigned)WS_W_XV, F.G, F.bx};
        EpiPlainBf16 E{WSP(bf16_t, WS_XK), WSP(bf16_t, WS_XVT)};
        pg8::gemm_phase<EpiPlainBf16, KvOrder, false>(F.lds, (const unsigned char*)F.ws, gstd, S, E, F.tid);
        SEAM(1);
    }
#pragma unroll 1
    for (int layer = 0; layer < DEPTH; ++layer) {
        const int pb = 2 + 11 * layer, eo = layer >> 1;
        if ((layer & 1) == 0) {
            if (PM(2) && IN(pb + 0)) { LAUNDER();
                { pg8::DenseOrder S; S.init(WS_HB, WS_W_EINA + (size_t)eo * PA_N * DM * 2, NTOK, PA_N, DM, DM, F.G, F.bx);
                  EpiRowScale E{WSP(bf16_t, WS_RA), PA_N, ssq, WSP(float, WS_ROPE), 7};
                  pg8::gemm_phase<EpiRowScale, pg8::DenseOrder, false>(F.lds, (const unsigned char*)F.ws, gstd, S, E, F.tid); }
                { pg8::DenseOrder S; S.init(WS_W_EINB + (size_t)eo * PB_N * DM * 2, WS_HB, PB_N, NTOK, DM, DM, F.G, F.bx);
                  EpiColScale E{(bf16_t*)(F.ws + WS_RA + RA_PROJB), ssq};
                  pg8::gemm_phase<EpiColScale, pg8::DenseOrder, false>(F.lds, (const unsigned char*)F.ws, gstd, S, E, F.tid); }
                SEAM(pb + 0);
            }
            if (PM(3) && IN(pb + 1)) { LAUNDER();
                LAUNDER(); phase_lru<false>(F, eo);
                __syncthreads();
                { CmpOrder S{(unsigned)WS_RA, (unsigned)(WS_W_CMP1 + (size_t)eo * 2 * 256 * 1024 * 2), F.G, F.bx};
                  EpiCompress E{WSP(bf16_t, WS_W_CMP2) + (size_t)eo * 2 * 64 * 128, (const float*)(F.ws + WS_W_CMP2 + 512 * 1024) + eo * 256, WSP(bf16_t, WS_KCMP), (bf16_t*)(F.ws + WS_KCMP + 512 * 1024)};
                  const pg8::Gemm gc{16 * PA_N, 1024, PA_N * 2, 128, 1024, 0, 1 << 30};
                  pg8::gemm_phase<EpiCompress, CmpOrder, false>(F.lds, (const unsigned char*)F.ws, gc, S, E, F.tid); }
                SEAM(pb + 1);
            }
            if (PM(4) && IN(pb + 2)) { LAUNDER();
                phase_lru<true>(F, eo);
                __syncthreads(); LAUNDER();
                phase_nsa(F);
                SEAM(pb + 2); }
        } else {
            if (PM(5) && IN(pb + 0)) { LAUNDER();
                pg8::DenseOrder S; S.init(WS_HB, WS_W_OIN + (size_t)eo * 3072 * DM * 2, NTOK, 3072, DM, DM, F.G, F.bx);
                EpiOddIn E{WSP(bf16_t, WS_RA), (bf16_t*)(F.ws + WS_RA + 64 * MiB), ssq};
                pg8::gemm_phase<EpiOddIn, pg8::DenseOrder, false>(F.lds, (const unsigned char*)F.ws, gstd, S, E, F.tid);
                SEAM(pb + 0);
            }
            if (PM(6) && IN(pb + 1)) { LAUNDER(); phase_oddconv(F, eo); if (pb + 3 < hi) GRIDBAR(); }
        }
        if (PM(7) && IN(pb + 3)) { LAUNDER();
            pg8::DenseOrder S; S.init(WS_YMIX, ((layer & 1) ? WS_W_OOUT : WS_W_EOUT) + (size_t)eo * DM * DM * 2, NTOK, DM, DM, DM, F.G, F.bx);
            EpiResid E{hb, ssq};
            pg8::gemm_phase<EpiResid, pg8::DenseOrder, false>(F.lds, (const unsigned char*)F.ws, gstd, S, E, F.tid);
            SEAM(pb + 3);
        }
        if (PM(8) && IN(pb + 4)) { LAUNDER();
            pg8::DenseOrder S; S.init(WS_HB, WS_W_XQ + (size_t)layer * DM * DM * 2, NTOK, DM, DM, DM, F.G, F.bx);
            EpiRowScale E{WSP(bf16_t, WS_RA), DM, ssq, nullptr, -1};
            pg8::gemm_phase<EpiRowScale, pg8::DenseOrder, false>(F.lds, (const unsigned char*)F.ws, gstd, S, E, F.tid);
            SEAM(pb + 4);
        }
        if (PM(9) && IN(pb + 5)) { LAUNDER(); phase_xattn(F, layer); SEAM(pb + 5); }
        if (PM(10) && IN(pb + 6)) { LAUNDER();
            pg8::DenseOrder S; S.init(WS_YMIX, WS_W_XO + (size_t)layer * DM * DM * 2, NTOK, DM, DM, DM, F.G, F.bx);
            EpiResid E{hb, ssq};
            pg8::gemm_phase<EpiResid, pg8::DenseOrder, false>(F.lds, (const unsigned char*)F.ws, gstd, S, E, F.tid);
            SEAM(pb + 6);
        }
        if (PM(11) && IN(pb + 7)) { LAUNDER(); phase_router(F, layer); SEAM(pb + 7); }
        if (PM(12) && IN(pb + 8)) { LAUNDER();
            moe_table(F, layer);
            MoeOrder S{(const LAS int*)(F.lds + MOE_TAB), WSP(int, WS_PERM), (unsigned)WS_HB, (unsigned)((layer & 1) ? WS_MOE_GU2 : WS_MOE_GU), F.G, F.bx, false};
            EpiGateUp E{WSP(bf16_t, WS_RA), (const float*)(F.ws + WS_ROUTE + 768 * 1024), (const float*)(F.ws + WS_ROUTE + 512 * 1024)};
            const pg8::Gemm gg{DM, DM, 128, 128, DM, NTOK - 1, 1 << 30};
            pg8::gemm_phase<EpiGateUp, MoeOrder, true>(F.lds, (const unsigned char*)F.ws, gg, S, E, F.tid);
            __syncthreads(); moe_convert_drain(F, layer + 1);
            SEAM(pb + 8);
        }
        if (PM(13) && IN(pb + 9)) { LAUNDER();
            moe_table(F, layer);
            MoeOrder S{(const LAS int*)(F.lds + MOE_TAB), WSP(int, WS_PERM), (unsigned)WS_RA, (unsigned)((layer & 1) ? WS_MOE_D2 : WS_MOE_D), F.G, F.bx, true};
            EpiDown<true> E{hb, ssq, (const float*)(F.ws + WS_ROUTE + 512 * 1024), 0};
            const pg8::Gemm gd{1024, 512, 128, 128, 1024, 0, 8};
            pg8::gemm_phase<EpiDown<true>, MoeOrder, false>(F.lds, (const unsigned char*)F.ws, gd, S, E, F.tid);
            __syncthreads(); moe_convert_drain(F, layer + 1);
            SEAM(pb + 9);
        }
    }
    if (PM(15) && IN(NPHASE - 1)) { LAUNDER(); phase_final(F); }
}

static int phase_kind(int p) {
    if (p == 0) return 0; if (p == 1) return 1; if (p == NPHASE - 1) return 15;
    const int layer = (p - 2) / 11, k = (p - 2) % 11;
    if (k == 10) return -1;
    if (k >= 3) return 4 + k;
    if ((layer & 1) == 0) return 2 + k;
    return k == 0 ? 5 : k == 1 ? 6 : -1;
}
typedef void (*KernelFn)(Args);
template <unsigned M> static KernelFn kfn() { return hybrid_fwd<M>; }
#if MK_PER_PHASE
static KernelFn kind_fn(int kind) {
    switch (kind) {
        case 0: return kfn<1u << 0>(); case 1: return kfn<1u << 1>(); case 2: return kfn<1u << 2>(); case 3: return kfn<1u << 3>();
        case 4: return kfn<1u << 4>(); case 5: return kfn<1u << 5>(); case 6: return kfn<1u << 6>(); case 7: return kfn<1u << 7>();
        case 8: return kfn<1u << 8>(); case 9: return kfn<1u << 9>(); case 10: return kfn<1u << 10>(); case 11: return kfn<1u << 11>();
        case 12: return kfn<1u << 12>(); case 13: return kfn<1u << 13>(); case 14: return kfn<1u << 14>(); default: return kfn<1u << 15>();
    }
}
#endif
extern "C" void kernel_launch(void* const* d_in, const int* in_sizes, int n_in, void* d_out, int out_size, void* d_ws, size_t ws_size, hipStream_t stream) {
    static int grid = 0;
    if (grid == 0) {
        if (n_in != 37 || out_size != NTOK * DM || ws_size < WS_END) { fprintf(stderr, "kernel_launch: unexpected problem (n_in %d, out %d, ws %zu)\n", n_in, out_size, ws_size); grid = -1; return; }
        int dev = 0, cus = 0;
        if (hipGetDevice(&dev) != hipSuccess || hipDeviceGetAttribute(&cus, hipDeviceAttributeMultiprocessorCount, dev) != hipSuccess) { grid = -1; return; }
#if MK_PER_PHASE
        for (int k = 0; k < 16; ++k) if (hipFuncSetAttribute((const void*)kind_fn(k), hipFuncAttributeMaxDynamicSharedMemorySize, LDS_BYTES) != hipSuccess) { fprintf(stderr, "kernel_launch: hipFuncSetAttribute failed\n"); grid = -1; return; }
#else
        if (hipFuncSetAttribute((const void*)kfn<0xFFFFu>(), hipFuncAttributeMaxDynamicSharedMemorySize, LDS_BYTES) != hipSuccess) { fprintf(stderr, "kernel_launch: hipFuncSetAttribute failed\n"); grid = -1; return; }
        int per_cu = 0;
        if (hipOccupancyMaxActiveBlocksPerMultiprocessor(&per_cu, (const void*)kfn<0xFFFFu>(), 512, LDS_BYTES) != hipSuccess || per_cu < 1) { fprintf(stderr, "kernel_launch: occupancy query says %d\n", per_cu); }
#endif
        (void)hipGetLastError();
        grid = cus;
    }
    if (grid < 0) return;
    (void)hipMemsetAsync((char*)d_ws + WS_CTL, 0, CTL_BYTES, stream);
    Args a{};
    for (int i = 0; i < 37; ++i) a.in[i] = d_in[i];
    a.out = (float*)d_out; a.ws = (unsigned char*)d_ws;
#if MK_PER_PHASE
    for (int p = 0; p < NPHASE; ++p) { const int kind = phase_kind(p); if (kind < 0) continue;
        a.ph_lo = p; a.ph_hi = p + 1; hipLaunchKernelGGL(kind_fn(kind), dim3(grid), dim3(512), LDS_BYTES, stream, a); }
#else
    a.ph_lo = 0; a.ph_hi = NPHASE; hipLaunchKernelGGL(kfn<0xFFFFu>(), dim3(grid), dim3(512), LDS_BYTES, stream, a);
#endif
}
```
